# Optimizing an MI355X kernel written in HIP

```python
import numpy as np
import jax, jax.numpy as jnp
from jax import lax

D_MODEL = 1024
BATCH = 2
SEQ = 8192
DEPTH = 2

GRID_W = 64
CTX_LEN = 256
M_HEADS = 4
M_DQK = 128
M_DV = 256
M_CHUNK = 64
M_QK = M_HEADS * M_DQK
M_V = M_HEADS * M_DV
M_GATES = 2 * 2 * M_HEADS
A_HEADS = 8
A_KV_HEADS = 2
A_GROUP = A_HEADS // A_KV_HEADS
A_HD = 128
A_Q = A_HEADS * A_HD
A_KV = A_KV_HEADS * A_HD
Q_BLOCK = 128
ROPE_THETA = 10000.0
C_WIDTH = D_MODEL
CONV_K = 3
D_FF = 4 * D_MODEL
N_MOD = 6
EPS = 1e-6
COL_SIZES = (M_QK, M_QK, M_V, M_V, M_GATES, A_Q, A_KV, A_KV, C_WIDTH, C_WIDTH, C_WIDTH, D_MODEL, D_MODEL, D_MODEL)
IN_COLS = sum(COL_SIZES)

kernel_name = 'hybrid_mlstm_gqa_shortconv_prefix_block'


def rms_norm(x, g):
    xf = x.astype(jnp.float32)
    y = xf * lax.rsqrt(jnp.mean(xf * xf, axis=-1, keepdims=True) + EPS)
    return (y * g).astype(x.dtype)


def modulate(x, shift, scale):
    return x * (1 + scale) + shift


def heads(t, n):
    return t.reshape(*t.shape[:-1], n, t.shape[-1] // n)


def split_columns(z):
    return jnp.split(z, np.cumsum(COL_SIZES)[:-1].tolist(), axis=-1)


def axial_rope_tables(n_tokens):
    rows = n_tokens // GRID_W
    row_idx = jnp.repeat(jnp.arange(rows), GRID_W)
    col_idx = jnp.tile(jnp.arange(GRID_W), rows)
    n_freq = A_HD // 4
    inv_freq = ROPE_THETA ** (-jnp.arange(n_freq, dtype=jnp.float32) / n_freq)
    pos = jnp.stack([row_idx, col_idx], axis=-1).astype(jnp.float32)
    ang = pos[:, :, None] * inv_freq
    return jnp.cos(ang), jnp.sin(ang)


def apply_rope(x, cos, sin):
    b, s, h, d = x.shape
    xr = x.astype(jnp.float32).reshape(b, s, h, 2, 2, d // 4)
    x1, x2 = xr[..., 0, :], xr[..., 1, :]
    cs = cos[None, :, None]
    sn = sin[None, :, None]
    out = jnp.stack([x1 * cs - x2 * sn, x1 * sn + x2 * cs], axis=-2)
    return out.reshape(b, s, h, d).astype(x.dtype)


def mlstm_scan(q, k, v, log_i, log_f, state):
    b, h, s, _ = q.shape
    dv = v.shape[-1]
    nc = s // M_CHUNK

    def chunks(t):
        return jnp.moveaxis(t.reshape(b, h, nc, M_CHUNK, *t.shape[3:]), 2, 0)

    tri = jnp.tril(jnp.ones((M_CHUNK, M_CHUNK), dtype=bool))

    def step(carry, inp):
        c_mat, n_vec, m = carry
        qc, kc, vc, ic, fc = inp
        bcum = jnp.cumsum(fc, axis=-1)
        d = jnp.where(tri, bcum[..., :, None] - bcum[..., None, :] + ic[..., None, :], -jnp.inf)
        inter = bcum + m[..., None]
        m_t = jnp.maximum(inter, jnp.max(d, axis=-1))
        w_intra = jnp.exp(d - m_t[..., None])
        w_inter = jnp.exp(inter - m_t)
        s_qk = jnp.einsum('bhtd,bhsd->bhts', qc, kc) * w_intra
        num = jnp.einsum('bhts,bhsv->bhtv', s_qk, vc) + w_inter[..., None] * jnp.einsum('bhtd,bhdv->bhtv', qc, c_mat)
        den = jnp.sum(s_qk, axis=-1) + w_inter * jnp.einsum('bhtd,bhd->bht', qc, n_vec)
        h_out = num / jnp.maximum(jnp.abs(den), jnp.exp(-m_t))[..., None]
        b_last = bcum[..., -1]
        g = b_last[..., None] - bcum + ic
        m_new = jnp.maximum(b_last + m, jnp.max(g, axis=-1))
        w_g = jnp.exp(g - m_new[..., None])
        w_c = jnp.exp(b_last + m - m_new)
        c_new = w_c[..., None, None] * c_mat + jnp.einsum('bhs,bhsd,bhsv->bhdv', w_g, kc, vc)
        n_new = w_c[..., None] * n_vec + jnp.einsum('bhs,bhsd->bhd', w_g, kc)
        return (c_new, n_new, m_new), h_out

    state, hs = lax.scan(step, state, (chunks(q), chunks(k), chunks(v), chunks(log_i), chunks(log_f)))
    return state, jnp.moveaxis(hs, 0, 2).reshape(b, h, s, dv)


def mlstm_inputs(parts, gate_b):
    mq, mk, mv, mg = parts[0], parts[1], parts[2], parts[4]
    bsz, n = mq.shape[:2]

    def hm(t):
        return jnp.swapaxes(heads(t, M_HEADS), 1, 2).astype(jnp.float32)

    gates = (mg.reshape(bsz, n, 2, 2, M_HEADS).astype(jnp.float32) + gate_b).transpose(0, 2, 3, 4, 1)
    return hm(mq) * (M_DQK ** -0.5), hm(mk), hm(mv), gates


def mlstm_bidirectional(q_l, k_l, v_l, g_l, q_c, k_c, v_c, g_c):
    bsz = q_l.shape[0]
    init = (jnp.zeros((bsz, M_HEADS, M_DQK, M_DV), jnp.float32),
            jnp.zeros((bsz, M_HEADS, M_DQK), jnp.float32),
            jnp.zeros((bsz, M_HEADS), jnp.float32))
    outs = []
    for direction in range(2):
        rev = (lambda t: jnp.flip(t, axis=2)) if direction == 1 else (lambda t: t)

        def run(q, k, v, g, state):
            return mlstm_scan(rev(q), rev(k), rev(v), rev(g[:, direction, 0]),
                              rev(jax.nn.log_sigmoid(g[:, direction, 1])), state)

        ctx_state, h_c = run(q_c, k_c, v_c, g_c, init)
        _, h_l = run(q_l, k_l, v_l, g_l, ctx_state)
        outs.append((rev(h_l), rev(h_c)))
    return outs[0][0] + outs[1][0], outs[0][1] + outs[1][1]


def mlstm_output(h, o_pre, gain):
    h = jnp.swapaxes(h, 1, 2)
    h = h * lax.rsqrt(jnp.mean(h * h, axis=-1, keepdims=True) + EPS)
    h = h.reshape(*h.shape[:2], M_V) * gain
    return (h * jax.nn.sigmoid(o_pre.astype(jnp.float32))).astype(o_pre.dtype)


def gqa_attend(q, k, v):
    s = jnp.einsum('bqhgd,bkhd->bhgqk', q, k).astype(jnp.float32) * (A_HD ** -0.5)
    p = jax.nn.softmax(s, axis=-1).astype(v.dtype)
    return jnp.einsum('bhgqk,bkhd->bqhgd', p, v)


def latent_attention(q, k_all, v_all):
    b, s = q.shape[:2]
    nb = s // Q_BLOCK
    qb = jnp.moveaxis(q.reshape(b, nb, Q_BLOCK, A_KV_HEADS, A_GROUP, A_HD), 1, 0)
    out = lax.map(lambda blk: gqa_attend(blk, k_all, v_all), qb)
    return jnp.moveaxis(out, 0, 1).reshape(b, s, A_Q)


def context_attention(q, k, v):
    b, n = q.shape[:2]
    return gqa_attend(q.reshape(b, n, A_KV_HEADS, A_GROUP, A_HD), k, v).reshape(b, n, A_Q)


def attn_q(parts, q_g):
    return rms_norm(heads(parts[5], A_HEADS), q_g)


def attn_kv(parts, k_g):
    return rms_norm(heads(parts[6], A_KV_HEADS), k_g), heads(parts[7], A_KV_HEADS)


def short_conv(u, w):
    up = jnp.pad(u, ((0, 0), (1, 1), (0, 0)))
    return w[0] * up[:, :-2] + w[1] * up[:, 1:-1] + w[2] * up[:, 2:]


def conv_branch(parts, w):
    u, gate_b, gate_c = parts[8], parts[9], parts[10]
    return gate_b * short_conv(gate_c * u, w)


def merge_branches(y_m, y_a, y_c, parts, w_pm, w_pa, w_pc, w_o):
    ga, gb, gc = parts[11], parts[12], parts[13]
    merged = (jax.nn.sigmoid(ga) * (y_m @ w_pm) + jax.nn.sigmoid(gb) * (y_a @ w_pa)
              + jax.nn.sigmoid(gc) * (y_c @ w_pc))
    return merged @ w_o


def squared_relu_mlp(h, w_up, w_down):
    return jnp.square(jax.nn.relu(h @ w_up)) @ w_down


def setup_inputs(seed: int = 0) -> dict:
    key = jax.random.key(seed)
    ks = jax.random.split(key, 24)
    nrm = jax.random.normal
    f32 = jnp.float32
    ib = 0.1 * nrm(ks[8], (DEPTH, 2, 1, M_HEADS), f32)
    fb = 3.0 + jnp.linspace(0.0, 3.0, M_HEADS, dtype=f32)[None, None, None, :] + 0.1 * nrm(ks[9], (DEPTH, 2, 1, M_HEADS), f32)
    return {
        'x': nrm(ks[0], (BATCH, SEQ, D_MODEL), f32),
        'c': nrm(ks[1], (BATCH, D_MODEL), f32),
        'ctx': nrm(ks[2], (BATCH, CTX_LEN, D_MODEL), f32),
        'c_ctx': nrm(ks[3], (D_MODEL,), f32),
        'w_ada': nrm(ks[4], (DEPTH, D_MODEL, N_MOD * D_MODEL), f32) * (0.5 * D_MODEL ** -0.5),
        'b_ada': 0.02 * nrm(ks[5], (DEPTH, N_MOD * D_MODEL), f32),
        'norm1': 1.0 + 0.05 * nrm(ks[6], (DEPTH, D_MODEL), f32),
        'norm2': 1.0 + 0.05 * nrm(ks[7], (DEPTH, D_MODEL), f32),
        'w_in': nrm(ks[10], (DEPTH, D_MODEL, IN_COLS), f32) * D_MODEL ** -0.5,
        'mlstm_gate_b': jnp.concatenate([ib, fb], axis=2),
        'mlstm_norm': 1.0 + 0.05 * nrm(ks[11], (DEPTH, M_V), f32),
        'q_norm': 1.0 + 0.05 * nrm(ks[12], (DEPTH, A_HD), f32),
        'k_norm': 1.0 + 0.05 * nrm(ks[13], (DEPTH, A_HD), f32),
        'conv_w': nrm(ks[14], (DEPTH, CONV_K, C_WIDTH), f32) * CONV_K ** -0.5,
        'w_proj_m': nrm(ks[15], (DEPTH, M_V, D_MODEL), f32) * M_V ** -0.5,
        'w_proj_a': nrm(ks[16], (DEPTH, A_Q, D_MODEL), f32) * A_Q ** -0.5,
        'w_proj_c': nrm(ks[17], (DEPTH, C_WIDTH, D_MODEL), f32) * C_WIDTH ** -0.5,
        'w_out': nrm(ks[18], (DEPTH, D_MODEL, D_MODEL), f32) * D_MODEL ** -0.5,
        'w_up': nrm(ks[19], (DEPTH, D_MODEL, D_FF), f32) * D_MODEL ** -0.5,
        'w_down': nrm(ks[20], (DEPTH, D_FF, D_MODEL), f32) * D_FF ** -0.5,
        'final_norm': 1.0 + 0.05 * nrm(ks[21], (D_MODEL,), f32),
    }


def reference(x, c, ctx, c_ctx, w_ada, b_ada, norm1, norm2, w_in, mlstm_gate_b, mlstm_norm, q_norm, k_norm,
              conv_w, w_proj_m, w_proj_a, w_proj_c, w_out, w_up, w_down, final_norm):
    cos, sin = axial_rope_tables(x.shape[1])
    for layer in range(DEPTH):
        need_ctx = layer < DEPTH - 1
        mod_l = jax.nn.silu(c) @ w_ada[layer] + b_ada[layer]
        mod_c = jax.nn.silu(c_ctx) @ w_ada[layer] + b_ada[layer]
        sh1, sc1, g1, sh2, sc2, g2 = jnp.split(mod_l[:, None, :], N_MOD, axis=-1)
        csh1, csc1, cg1, csh2, csc2, cg2 = jnp.split(mod_c, N_MOD, axis=-1)

        p_l = split_columns(modulate(rms_norm(x, norm1[layer]), sh1, sc1) @ w_in[layer])
        p_c = split_columns(modulate(rms_norm(ctx, norm1[layer]), csh1, csc1) @ w_in[layer])

        mq_l, mk_l, mv_l, mg_l = mlstm_inputs(p_l, mlstm_gate_b[layer])
        mq_c, mk_c, mv_c, mg_c = mlstm_inputs(p_c, mlstm_gate_b[layer])
        hm_l, hm_c = mlstm_bidirectional(mq_l, mk_l, mv_l, mg_l, mq_c, mk_c, mv_c, mg_c)
        ym_l = mlstm_output(hm_l, p_l[3], mlstm_norm[layer])

        aq_l = apply_rope(attn_q(p_l, q_norm[layer]), cos, sin)
        ak_l, av_l = attn_kv(p_l, k_norm[layer])
        ak_l = apply_rope(ak_l, cos, sin)
        ak_c, av_c = attn_kv(p_c, k_norm[layer])
        ya_l = latent_attention(aq_l, jnp.concatenate([ak_c, ak_l], axis=1), jnp.concatenate([av_c, av_l], axis=1))

        yc_l = conv_branch(p_l, conv_w[layer])

        x = x + g1 * merge_branches(ym_l, ya_l, yc_l, p_l, w_proj_m[layer], w_proj_a[layer], w_proj_c[layer], w_out[layer])
        x = x + g2 * squared_relu_mlp(modulate(rms_norm(x, norm2[layer]), sh2, sc2), w_up[layer], w_down[layer])

        if need_ctx:
            ym_c = mlstm_output(hm_c, p_c[3], mlstm_norm[layer])
            ya_c = context_attention(attn_q(p_c, q_norm[layer]), ak_c, av_c)
            yc_c = conv_branch(p_c, conv_w[layer])
            ctx = ctx + cg1 * merge_branches(ym_c, ya_c, yc_c, p_c, w_proj_m[layer], w_proj_a[layer], w_proj_c[layer], w_out[layer])
            ctx = ctx + cg2 * squared_relu_mlp(modulate(rms_norm(ctx, norm2[layer]), csh2, csc2), w_up[layer], w_down[layer])
    return rms_norm(x, final_norm)
```

```cpp
#include <hip/hip_runtime.h>
#include <hip/hip_cooperative_groups.h>
#include <cstdio>
#include <cstdint>
namespace cg = cooperative_groups;

#ifndef MULTI_LAUNCH
#define MULTI_LAUNCH 0
#endif

typedef unsigned short bf16_t;
typedef short s16x8 __attribute__((ext_vector_type(8)));
typedef short s16x4 __attribute__((ext_vector_type(4)));
typedef float f32x4 __attribute__((ext_vector_type(4)));
typedef float f32x2 __attribute__((ext_vector_type(2)));
typedef unsigned u32x4 __attribute__((ext_vector_type(4)));
typedef unsigned u32x2 __attribute__((ext_vector_type(2)));

constexpr int D = 1024, TR = 16896, PB = 8448, NCTX = 256, SEQ = 8192, INC = 10768, DFF = 4096;
constexpr int NMT = TR / 128;
constexpr float EPS = 1e-6f;
constexpr float QSCALE = 0.08838834764831845f * 1.4426950408889634f;
constexpr float MQSCALE = 0.08838834764831845f;

constexpr size_t E1 = (size_t)TR * 1024 * 2;
constexpr size_t OFF_CNT = 0;
constexpr size_t OFF_ROPE = 4096;
constexpr size_t OFF_MOD = OFF_ROPE + 128 * 32 * 8;
constexpr size_t OFF_GATES = OFF_MOD + 2 * 3 * 6144 * 4;
constexpr size_t OFF_CTXB = OFF_GATES + (size_t)TR * 16 * 4;
constexpr size_t OFF_W = OFF_CTXB + (size_t)512 * 1024 * 4;
constexpr size_t W_IN = 0, W_PM = W_IN + (size_t)10752 * 1024 * 2, W_PA = W_PM + 2097152, W_PC = W_PA + 2097152, W_O = W_PC + 2097152,
                 W_UP = W_O + 2097152, W_DN = W_UP + 8388608, W_END = W_DN + 8388608;
constexpr size_t OFF_S = OFF_W + W_END;
constexpr size_t OFF_PO = OFF_S + 8 * E1;
constexpr size_t OFF_ML = OFF_PO + (size_t)2 * 256 * 128 * 128 * 2;
constexpr size_t OFF_GW = OFF_ML + (size_t)2 * 256 * 128 * 8;
constexpr size_t WS_NEED = OFF_GW + (size_t)2 * 16 * 1024 * 4;

struct Params {
  const float *x, *c, *ctx, *c_ctx, *w_ada, *b_ada, *norm1, *norm2, *w_in, *gate_b, *mnorm, *qn, *kn, *conv_w, *wpm, *wpa, *wpc, *wout, *wup, *wdn, *fnorm;
  float* out; char* ws;
};

__device__ __forceinline__ int otid() { int t = threadIdx.x; asm volatile("" : "+v"(t)); return t; }
__device__ __forceinline__ float shx(float x, int m, int lane) { return __builtin_bit_cast(float, __builtin_amdgcn_ds_bpermute((lane ^ m) << 2, __builtin_bit_cast(int, x))); }
__device__ __forceinline__ float shl_(float x, int src) { return __builtin_bit_cast(float, __builtin_amdgcn_ds_bpermute(src << 2, __builtin_bit_cast(int, x))); }
__device__ __forceinline__ bf16_t* slot(const Params& P, int s) { return (bf16_t*)(P.ws + OFF_S + (size_t)s * E1); }
__device__ __forceinline__ bf16_t* wbuf(const Params& P, size_t off) { return (bf16_t*)(P.ws + OFF_W + off); }

__device__ __forceinline__ unsigned pk2(float lo, float hi) { unsigned r; asm("v_cvt_pk_bf16_f32 %0, %1, %2" : "=v"(r) : "v"(lo), "v"(hi)); return r; }
__device__ __forceinline__ bf16_t f2bf(float f) { return (bf16_t)(pk2(f, f) & 0xffffu); }
__device__ __forceinline__ float bflo(unsigned u) { return __uint_as_float(u << 16); }
__device__ __forceinline__ float bfhi(unsigned u) { return __uint_as_float(u & 0xffff0000u); }
__device__ __forceinline__ float sigmoidf_(float x) { return 1.f / (1.f + __expf(-x)); }

__device__ __forceinline__ const float* xsrc_row(const Params& P, bool useInput, int R) {
  const int b = R / PB, p = R - b * PB;
  if (p < NCTX) return (useInput ? P.ctx : (const float*)(P.ws + OFF_CTXB)) + (size_t)(b * NCTX + p) * D;
  return (useInput ? P.x : (const float*)P.out) + (size_t)(b * SEQ + p - NCTX) * D;
}
__device__ __forceinline__ float* xdst_row(const Params& P, int R) {
  const int b = R / PB, p = R - b * PB;
  if (p < NCTX) return (float*)(P.ws + OFF_CTXB) + (size_t)(b * NCTX + p) * D;
  return P.out + (size_t)(b * SEQ + p - NCTX) * D;
}
__device__ __forceinline__ const float* modrow(const Params& P, int layer, int R0) {
  const int b = R0 / PB, p = R0 - b * PB;
  const int mi = (p < NCTX) ? 2 : b;
  return (const float*)(P.ws + OFF_MOD) + (size_t)(layer * 3 + mi) * 6144;
}

constexpr int LDT = 72;
constexpr int LDG = 40;
typedef float f32x16 __attribute__((ext_vector_type(16)));
template <int MW, int NT>
__device__ __forceinline__ void gemm_core(const bf16_t* __restrict__ A, int lda, const bf16_t* __restrict__ Bt, int ldb, int K, f32x16 (&acc)[MW / 2][NT / 2], bf16_t* sm) {
  const int tid = otid(), lane = tid & 63, w = tid >> 6, r = lane & 31, h = lane >> 5;
  const int ldr = tid >> 3, ldk = (tid & 7) * 8;
  constexpr int NA = 2 * MW, NB = NT / 2, LDK = 72;
  u32x4 ra[NA], rb[NB];
  const bf16_t* ap = A + (size_t)ldr * lda + ldk;
  const bf16_t* bp = Bt + (size_t)ldr * ldb + ldk;
  bf16_t* As = sm; bf16_t* Bs = sm + 64 * MW * LDK;
  const int nk = K >> 6;
  auto gload = [&](int kt) {
#pragma unroll
    for (int i = 0; i < NA; ++i) ra[i] = *(const u32x4*)(ap + (size_t)(32 * i) * lda + kt * 64);
#pragma unroll
    for (int i = 0; i < NB; ++i) rb[i] = *(const u32x4*)(bp + (size_t)(32 * i) * ldb + kt * 64);
  };
  gload(0);
  for (int kt = 0; kt < nk; ++kt) {
    __syncthreads();
#pragma unroll
    for (int i = 0; i < NA; ++i) *(u32x4*)(As + (ldr + 32 * i) * LDK + ldk) = ra[i];
#pragma unroll
    for (int i = 0; i < NB; ++i) *(u32x4*)(Bs + (ldr + 32 * i) * LDK + ldk) = rb[i];
    __syncthreads();
    gload(min(kt + 1, nk - 1));
    __builtin_amdgcn_s_setprio(1);
#pragma unroll
    for (int ks = 0; ks < 4; ++ks) {
      s16x8 af[MW / 2], bfr[NT / 2];
#pragma unroll
      for (int m = 0; m < MW / 2; ++m) af[m] = *(const s16x8*)(As + (16 * MW * w + 32 * m + r) * LDK + 16 * ks + 8 * h);
#pragma unroll
      for (int n = 0; n < NT / 2; ++n) bfr[n] = *(const s16x8*)(Bs + (32 * n + r) * LDK + 16 * ks + 8 * h);
#pragma unroll
      for (int m = 0; m < MW / 2; ++m)
#pragma unroll
        for (int n = 0; n < NT / 2; ++n) acc[m][n] = __builtin_amdgcn_mfma_f32_32x32x16_bf16(af[m], bfr[n], acc[m][n], 0, 0, 0);
    }
    __builtin_amdgcn_s_setprio(0);
  }
  __syncthreads();
}

template <int MW, int NT>
__device__ __forceinline__ void zero_acc(f32x16 (&acc)[MW / 2][NT / 2]) {
#pragma unroll
  for (int m = 0; m < MW / 2; ++m)
#pragma unroll
    for (int n = 0; n < NT / 2; ++n)
#pragma unroll
      for (int e = 0; e < 16; ++e) acc[m][n][e] = 0.f;
}
__device__ __forceinline__ int big_R0(int bt) { return (bt >> 5) * PB + NCTX + (bt & 31) * 256; }
__device__ __forceinline__ int small_R0(int st) { return (st >> 1) * PB + (st & 1) * 128; }

__device__ __forceinline__ int winmap(int n) {
  if (n < 3072) return n;
  if (n < 4608) return n + 16;
  if (n < 5632) return 5648 + (n - 4608);
  if (n < 7680) { const int j = (n - 5632) >> 7, c = (n - 5632) & 127; return c < 64 ? 4624 + 64 * j + c : 6672 + 64 * j + (c - 64); }
  return 7696 + (n - 7680);
}
__device__ void convert_tile(const float* __restrict__ src, int lds, int srccol0, bf16_t* __restrict__ dst, int K, int kt, int n0, float* tl) {
  const int tid = otid();
  __syncthreads();
#pragma unroll
  for (int i = 0; i < 4; ++i) {
    const int k = i * 16 + (tid >> 4), n4 = (tid & 15) * 4;
    const f32x4 v = *(const f32x4*)(src + (size_t)(kt * 64 + k) * lds + srccol0 + n4);
    tl[k * 65 + n4] = v[0]; tl[k * 65 + n4 + 1] = v[1]; tl[k * 65 + n4 + 2] = v[2]; tl[k * 65 + n4 + 3] = v[3];
  }
  __syncthreads();
  const int n = tid >> 2, ks = (tid & 3) * 16;
  u32x4 o0, o1;
  o0.x = pk2(tl[(ks + 0) * 65 + n], tl[(ks + 1) * 65 + n]); o0.y = pk2(tl[(ks + 2) * 65 + n], tl[(ks + 3) * 65 + n]);
  o0.z = pk2(tl[(ks + 4) * 65 + n], tl[(ks + 5) * 65 + n]); o0.w = pk2(tl[(ks + 6) * 65 + n], tl[(ks + 7) * 65 + n]);
  o1.x = pk2(tl[(ks + 8) * 65 + n], tl[(ks + 9) * 65 + n]); o1.y = pk2(tl[(ks + 10) * 65 + n], tl[(ks + 11) * 65 + n]);
  o1.z = pk2(tl[(ks + 12) * 65 + n], tl[(ks + 13) * 65 + n]); o1.w = pk2(tl[(ks + 14) * 65 + n], tl[(ks + 15) * 65 + n]);
  bf16_t* d = dst + (size_t)(n0 + n) * K + kt * 64 + ks;
  *(u32x4*)d = o0; *(u32x4*)(d + 8) = o1;
}
constexpr int CONV_A_ITEMS = 2688 + 4 * 256, CONV_B_ITEMS = 2048;
__device__ void convert_item(const Params& P, int layer, int set, int item, float* tl) {
  if (set == 0) {
    if (item < 2688) { const int nt = item % 168, kt = item / 168; convert_tile(P.w_in + (size_t)layer * 1024 * INC, INC, winmap(nt * 64), wbuf(P, W_IN), 1024, kt, nt * 64, tl); return; }
    item -= 2688; const int j = item >> 8, t = item & 255, nt = t & 15, kt = t >> 4;
    const float* src = (j == 0 ? P.wpm : j == 1 ? P.wpa : j == 2 ? P.wpc : P.wout) + (size_t)layer * 1024 * 1024;
    convert_tile(src, 1024, nt * 64, wbuf(P, W_PM + (size_t)j * 2097152), 1024, kt, nt * 64, tl);
  } else {
    if (item < 1024) { const int nt = item & 63, kt = item >> 6; convert_tile(P.wup + (size_t)layer * 1024 * 4096, 4096, nt * 64, wbuf(P, W_UP), 1024, kt, nt * 64, tl); }
    else { item -= 1024; const int nt = item & 15, kt = item >> 4; convert_tile(P.wdn + (size_t)layer * 4096 * 1024, 1024, nt * 64, wbuf(P, W_DN), 4096, kt, nt * 64, tl); }
  }
}

__device__ void mod_item(const Params& P, int item, float* sv) {
  const int tid = otid(), l = item / 96, j0 = (item % 96) * 64;
  __syncthreads();
  for (int idx = tid; idx < 3072; idx += 256) { const int mi = idx >> 10, k = idx & 1023; const float v = mi < 2 ? P.c[mi * 1024 + k] : P.c_ctx[k]; sv[idx] = v / (1.f + __expf(-v)); }
  __syncthreads();
  const int cl = tid & 15, kg = tid >> 4;
  f32x4 a0 = {0.f, 0.f, 0.f, 0.f}, a1 = a0, a2 = a0;
  const float* wp = P.w_ada + ((size_t)l * 1024 + kg * 64) * 6144 + j0 + 4 * cl;
#pragma unroll 8
  for (int k = 0; k < 64; ++k) {
    const f32x4 wv = *(const f32x4*)(wp + (size_t)k * 6144);
    a0 += wv * sv[kg * 64 + k]; a1 += wv * sv[1024 + kg * 64 + k]; a2 += wv * sv[2048 + kg * 64 + k];
  }
  float* red = sv + 3072;
  *(f32x4*)(red + (kg * 3 + 0) * 64 + 4 * cl) = a0; *(f32x4*)(red + (kg * 3 + 1) * 64 + 4 * cl) = a1; *(f32x4*)(red + (kg * 3 + 2) * 64 + 4 * cl) = a2;
  __syncthreads();
  if (tid < 192) { const int m = tid >> 6, jl = tid & 63; float sacc = P.b_ada[l * 6144 + j0 + jl];
#pragma unroll
    for (int q = 0; q < 16; ++q) sacc += red[(q * 3 + m) * 64 + jl];
    ((float*)(P.ws + OFF_MOD))[(size_t)(l * 3 + m) * 6144 + j0 + jl] = sacc; }
}
__device__ void rope_item(const Params& P) {
  const int tid = otid();
  f32x2* rt = (f32x2*)(P.ws + OFF_ROPE);
  for (int e = tid; e < 4096; e += 256) {
    const int pos = e >> 5, f = e & 31;
    double inv = 1.0; for (int q = 0; q < f; ++q) inv *= 0.7498942093324559;
    const float invf = (float)inv; const float angf = (float)pos * invf;
    const double x = (double)angf;
    const double n = rint(x / 6.283185307179586), r = x - n * 6.283185307179586, r2 = r * r;
    double ts = 1.0, tc = 1.0, ss = 1.0, sc = 1.0;
    for (int k = 1; k <= 14; ++k) { tc *= -r2 / (double)((2 * k - 1) * (2 * k)); sc += tc; ts *= -r2 / (double)((2 * k) * (2 * k + 1)); ss += ts; }
    rt[e] = (f32x2){(float)sc, (float)(r * ss)};
  }
}
__device__ void phase_prologue(const Params& P, char* sm) {
  for (int i = blockIdx.x * 256 + otid(); i < 512 * 1024 / 4; i += gridDim.x * 256) ((f32x4*)(P.ws + OFF_CTXB))[i] = ((const f32x4*)P.ctx)[i];
  const int NI = 192 + 1 + 2 + CONV_A_ITEMS + CONV_B_ITEMS;
  for (int it = blockIdx.x; it < NI; it += gridDim.x) {
    if (it < 192) mod_item(P, it, (float*)sm);
    else if (it == 192) rope_item(P);
    else if (it < 195) {
      const int l = it - 193;
      const float* wi = P.w_in + (size_t)l * 1024 * INC + 3072; float* gw = (float*)(P.ws + OFF_GW) + l * 16384;
      for (int idx = otid(); idx < 16384; idx += 256) { const int k = idx >> 4, j = idx & 15; gw[j * 1024 + k] = wi[(size_t)k * INC + j]; }
    }
    else if (it < 195 + CONV_A_ITEMS) convert_item(P, 0, 0, it - 195, (float*)sm);
    else convert_item(P, 0, 1, it - 195 - CONV_A_ITEMS, (float*)sm);
  }
}

__device__ void phase_norm(const Params& P, int layer, int which, char* smc) {
  float* wgt = (float*)smc;
  const int tid = otid(), lane = tid & 63, w = tid >> 6;
  if (which == 0) {
    const f32x4* gw = (const f32x4*)(P.ws + OFF_GW) + layer * 4096;
#pragma unroll
    for (int i = 0; i < 16; ++i) ((f32x4*)wgt)[tid + 256 * i] = gw[tid + 256 * i];
    __syncthreads();
  }
  const float* gvec = (which == 0 ? P.norm1 : P.norm2) + layer * 1024;
  bf16_t* hout = slot(P, 0);
  auto loadrow = [&](int R, f32x4 (&xv)[4]) {
    const float* xr = (which == 0) ? xsrc_row(P, layer == 0, R) : (const float*)xdst_row(P, R);
#pragma unroll
    for (int i = 0; i < 4; ++i) xv[i] = *(const f32x4*)(xr + 256 * i + lane * 4);
  };
  const int rstride = gridDim.x * 4;
  f32x4 xn[4];
  int R = blockIdx.x * 4 + w;
  if (R < TR) loadrow(R, xn);
  for (; R < TR; R += rstride) {
    f32x4 xv[4];
#pragma unroll
    for (int i = 0; i < 4; ++i) xv[i] = xn[i];
    if (R + rstride < TR) loadrow(R + rstride, xn);
    const int b = R / PB, p = R - b * PB;
    if (layer == 1 && which == 1 && p < NCTX) continue;
    const float* mod = (const float*)(P.ws + OFF_MOD) + (size_t)(layer * 3 + (p < NCTX ? 2 : b)) * 6144 + (which == 0 ? 0 : 3072);
    f32x4 gv4[4], sh4[4], sc4[4];
#pragma unroll
    for (int i = 0; i < 4; ++i) { const int col = 256 * i + lane * 4; gv4[i] = *(const f32x4*)(gvec + col); sh4[i] = *(const f32x4*)(mod + col); sc4[i] = *(const f32x4*)(mod + 1024 + col); }
    float ss = 0.f;
#pragma unroll
    for (int i = 0; i < 4; ++i) ss += xv[i][0] * xv[i][0] + xv[i][1] * xv[i][1] + xv[i][2] * xv[i][2] + xv[i][3] * xv[i][3];
#pragma unroll
    for (int o = 32; o >= 1; o >>= 1) ss += shx(ss, o, lane);
    const float rstd = rsqrtf(ss * (1.f / 1024.f) + EPS);
#pragma unroll
    for (int i = 0; i < 4; ++i) {
#pragma unroll
      for (int e = 0; e < 4; ++e) xv[i][e] = (xv[i][e] * rstd * gv4[i][e]) * (1.f + sc4[i][e]) + sh4[i][e];
    }
#pragma unroll
    for (int i = 0; i < 4; ++i) {
      u32x2 o; o.x = pk2(xv[i][0], xv[i][1]); o.y = pk2(xv[i][2], xv[i][3]);
      *(u32x2*)(hout + (size_t)R * 1024 + 256 * i + lane * 4) = o;
    }
    if (which == 0) {
      float sj[16];
#pragma unroll
      for (int j = 0; j < 16; ++j) {
        float sacc = 0.f;
#pragma unroll
        for (int i = 0; i < 4; ++i) { const f32x4 wv = *(const f32x4*)(wgt + j * 1024 + 256 * i + lane * 4); sacc += xv[i][0] * wv[0] + xv[i][1] * wv[1] + xv[i][2] * wv[2] + xv[i][3] * wv[3]; }
        sj[j] = sacc;
      }
      const bool b5 = lane & 32, b4 = lane & 16, b3 = lane & 8, b2 = lane & 4;
      float a8[8], a4[4], a2[2];
#pragma unroll
      for (int j = 0; j < 8; ++j) { const float keep = b5 ? sj[8 + j] : sj[j], send = b5 ? sj[j] : sj[8 + j]; a8[j] = keep + shx(send, 32, lane); }
#pragma unroll
      for (int j = 0; j < 4; ++j) { const float keep = b4 ? a8[4 + j] : a8[j], send = b4 ? a8[j] : a8[4 + j]; a4[j] = keep + shx(send, 16, lane); }
#pragma unroll
      for (int j = 0; j < 2; ++j) { const float keep = b3 ? a4[2 + j] : a4[j], send = b3 ? a4[j] : a4[2 + j]; a2[j] = keep + shx(send, 8, lane); }
      float e = (b2 ? a2[1] : a2[0]) + shx(b2 ? a2[0] : a2[1], 4, lane);
      e += shx(e, 1, lane); e += shx(e, 2, lane);
      if ((lane & 3) == 0) ((float*)(P.ws + OFF_GATES))[(size_t)R * 16 + (lane >> 2)] = e + P.gate_b[layer * 16 + (lane >> 2)];
    }
  }
  if (which == 1 && layer == 0) { for (int it = blockIdx.x; it < CONV_A_ITEMS; it += gridDim.x) convert_item(P, 1, 0, it, (float*)smc); }
  if (which == 0 && layer == 1) { for (int it = blockIdx.x; it < CONV_B_ITEMS; it += gridDim.x) convert_item(P, 1, 1, it, (float*)smc); }
}

__device__ __forceinline__ bool gemm_unit(int i, int NTN, bool withCtx, bool& isBig, int& R0, int& nt) {
  const int x = blockIdx.x & 7, loc = blockIdx.x >> 3, nloc = gridDim.x >> 3;
  int j = loc + i * nloc;
  if (j < 8 * NTN) {
    const int jl = j & 63;
    isBig = true; nt = (j >> 6) * 8 + ((jl & 1) | ((jl >> 4) << 1)); R0 = big_R0(8 * x + ((jl >> 1) & 7)); return true;
  }
  j -= 8 * NTN;
  if (!withCtx) return false;
  const int sidx = x + 8 * j;
  if (sidx >= 4 * NTN) return false;
  isBig = false; nt = sidx % NTN; R0 = small_R0(sidx / NTN); return true;
}

template <int NT>
__device__ __forceinline__ void flush_pass(const bf16_t* smw, bf16_t* dst, int ld, int lane) {
  constexpr int LDW = 16 * NT + 8, CPR = 2 * NT;
#pragma unroll
  for (int j = 0; j < NT; ++j) {
    const int c = lane + 64 * j, row = c / CPR, cc = c % CPR;
    const u32x4 v = *(const u32x4*)(smw + row * LDW + cc * 8);
    *(u32x4*)(dst + (size_t)row * ld + cc * 8) = v;
  }
}
template <int MW, int LD>
__device__ __forceinline__ void store_nat(const f32x16 (&acc)[MW / 2][4], bf16_t* base, float scale, bf16_t* sm, int w, int lane) {
  const int r = lane & 31, h = lane >> 5;
  bf16_t* smw = sm + w * 32 * 136;
#pragma unroll
  for (int m = 0; m < MW / 2; ++m) {
#pragma unroll
    for (int q = 0; q < 4; ++q)
#pragma unroll
      for (int i = 0; i < 4; ++i)
#pragma unroll
        for (int n = 0; n < 4; ++n) smw[(8 * q + 4 * h + i) * 136 + 32 * n + r] = f2bf(acc[m][n][4 * q + i] * scale);
    flush_pass<8>(smw, base + (size_t)(16 * MW * w + 32 * m) * LD, LD, lane);
  }
}
template <int MW>
__device__ __forceinline__ void store_tr(const f32x16 (&acc)[MW / 2][4], bf16_t* base, int w, int lane) {
  const int r = lane & 31, h = lane >> 5;
  bf16_t* p = base + (size_t)r * PB + 16 * MW * w + 4 * h;
#pragma unroll
  for (int m = 0; m < MW / 2; ++m)
#pragma unroll
    for (int n = 0; n < 4; ++n)
#pragma unroll
      for (int q = 0; q < 4; ++q) { u32x2 o; o.x = pk2(acc[m][n][4 * q], acc[m][n][4 * q + 1]); o.y = pk2(acc[m][n][4 * q + 2], acc[m][n][4 * q + 3]); *(u32x2*)(p + (size_t)(32 * n) * PB + 32 * m + 8 * q) = o; }
}
template <int MW>
__device__ __forceinline__ void inproj_tile(const Params& P, int layer, int R0, int nt_, bf16_t* sm) {
  const int tid = otid(), lane = tid & 63, w = tid >> 6, r = lane & 31, h = lane >> 5;
  const bf16_t* h1 = slot(P, 0);
  const bf16_t* WinT = wbuf(P, W_IN);
  bf16_t* cu = slot(P, 1); bf16_t* cB = slot(P, 2);
  bf16_t* mq = slot(P, 3); bf16_t* mk = mq + (size_t)TR * 512;
  bf16_t* mkT = slot(P, 4); bf16_t* ak = mkT + (size_t)TR * 512; bf16_t* avT = ak + (size_t)TR * 256;
  bf16_t* mvT = slot(P, 5); bf16_t* mo = slot(P, 6); bf16_t* aq = slot(P, 7);
  const f32x2* rope = (const f32x2*)(P.ws + OFF_ROPE);
  f32x16 acc[MW / 2][4]; zero_acc<MW, 8>(acc);
  gemm_core<MW, 8>(h1 + (size_t)R0 * 1024, 1024, WinT + (size_t)nt_ * 128 * 1024, 1024, 1024, acc, sm);
  const int b = R0 / PB, p0 = R0 - b * PB, rw = 16 * MW * w;
  if (nt_ < 4) store_nat<MW, 512>(acc, mq + (size_t)R0 * 512 + nt_ * 128, MQSCALE, sm, w, lane);
  else if (nt_ < 8) { store_nat<MW, 512>(acc, mk + (size_t)R0 * 512 + (nt_ - 4) * 128, 1.f, sm, w, lane); store_tr<MW>(acc, mkT + (size_t)(b * 512 + (nt_ - 4) * 128) * PB + p0, w, lane); }
  else if (nt_ < 16) store_tr<MW>(acc, mvT + (size_t)(b * 1024 + (nt_ - 8) * 128) * PB + p0, w, lane);
  else if (nt_ < 24) store_nat<MW, 1024>(acc, mo + (size_t)R0 * 1024 + (nt_ - 16) * 128, 1.f, sm, w, lane);
  else if (nt_ < 34) {
    const bool isq = nt_ < 32;
    const float* gn = (isq ? P.qn : P.kn) + layer * 128;
    float gv[4];
#pragma unroll
    for (int n = 0; n < 4; ++n) gv[n] = gn[32 * n + r];
    const float scale = isq ? QSCALE : 1.f;
    bf16_t* smw = sm + w * 32 * 136;
#pragma unroll
    for (int m = 0; m < MW / 2; ++m) {
#pragma unroll
      for (int q = 0; q < 4; ++q)
#pragma unroll
        for (int i = 0; i < 4; ++i) {
          float v[4]; float ss = 0.f;
#pragma unroll
          for (int n = 0; n < 4; ++n) { v[n] = acc[m][n][4 * q + i]; ss += v[n] * v[n]; }
          ss += shx(ss, 1, lane); ss += shx(ss, 2, lane); ss += shx(ss, 4, lane); ss += shx(ss, 8, lane); ss += shx(ss, 16, lane);
          const float rstd = rsqrtf(ss * (1.f / 128.f) + EPS);
#pragma unroll
          for (int n = 0; n < 4; ++n) v[n] = v[n] * rstd * gv[n];
          if (p0 >= NCTX) {
            const int sidx = p0 - NCTX + rw + 32 * m + 8 * q + 4 * h + i, ri = sidx >> 6, ci = sidx & 63;
            const f32x2 a = rope[ri * 32 + r]; const float x1 = v[0], x2 = v[1];
            v[0] = x1 * a.x - x2 * a.y; v[1] = x1 * a.y + x2 * a.x;
            const f32x2 c2 = rope[ci * 32 + r]; const float y1 = v[2], y2 = v[3];
            v[2] = y1 * c2.x - y2 * c2.y; v[3] = y1 * c2.y + y2 * c2.x;
          }
#pragma unroll
          for (int n = 0; n < 4; ++n) smw[(8 * q + 4 * h + i) * 136 + 32 * n + r] = f2bf(v[n] * scale);
        }
      if (isq) flush_pass<8>(smw, aq + (size_t)(R0 + rw + 32 * m) * 1024 + (nt_ - 24) * 128, 1024, lane);
      else flush_pass<8>(smw, ak + (size_t)(R0 + rw + 32 * m) * 256 + (nt_ - 32) * 128, 256, lane);
    }
  }
  else if (nt_ < 36) store_tr<MW>(acc, avT + (size_t)(b * 256 + (nt_ - 34) * 128) * PB + p0, w, lane);
  else if (nt_ < 44) store_nat<MW, 1024>(acc, cB + (size_t)R0 * 1024 + (nt_ - 36) * 128, 1.f, sm, w, lane);
  else {
    bf16_t* smw = sm + w * 32 * 72;
#pragma unroll
    for (int m = 0; m < MW / 2; ++m) {
#pragma unroll
      for (int q = 0; q < 4; ++q)
#pragma unroll
        for (int i = 0; i < 4; ++i)
#pragma unroll
          for (int n = 0; n < 2; ++n) smw[(8 * q + 4 * h + i) * 72 + 32 * n + r] = f2bf(acc[m][n][4 * q + i] * acc[m][n + 2][4 * q + i]);
      flush_pass<4>(smw, cu + (size_t)(R0 + rw + 32 * m) * 1024 + 64 * (nt_ - 44), 1024, lane);
    }
  }
}
__device__ void phase_inproj(const Params& P, int layer, char* smc) {
  bf16_t* sm = (bf16_t*)smc;
  for (int i = 0;; ++i) {
    bool big; int R0, nt;
    if (!gemm_unit(i, 60, true, big, R0, nt)) break;
    if (big) inproj_tile<4>(P, layer, R0, nt, sm); else inproj_tile<2>(P, layer, R0, nt, sm);
  }
}

__device__ void phase_conv(const Params& P, int layer) {
  const bf16_t* cu = slot(P, 1); bf16_t* cB = slot(P, 2);
  const float* cw = P.conv_w + (size_t)layer * 3 * 1024;
  const int tid = otid();
  const int stride = gridDim.x * 256;
  int idx = blockIdx.x * 256 + tid;
  const int ch = (idx & 127) * 8;
  float w0[8], w1[8], w2[8];
#pragma unroll
  for (int e = 0; e < 8; ++e) { w0[e] = cw[ch + e]; w1[e] = cw[1024 + ch + e]; w2[e] = cw[2048 + ch + e]; }
  const u32x4 z = {0u, 0u, 0u, 0u};
  auto loaditem = [&](int id, u32x4& c0, u32x4& c1, u32x4& c2, u32x4& bg) {
    const int R = id >> 7, p = R % PB;
    const bool hasL = !(p == 0 || p == NCTX), hasR = !(p == NCTX - 1 || p == PB - 1);
    c1 = *(const u32x4*)(cu + (size_t)R * 1024 + ch);
    c0 = hasL ? *(const u32x4*)(cu + (size_t)(R - 1) * 1024 + ch) : z;
    c2 = hasR ? *(const u32x4*)(cu + (size_t)(R + 1) * 1024 + ch) : z;
    bg = *(const u32x4*)(cB + (size_t)R * 1024 + ch);
  };
  u32x4 n0 = z, n1 = z, n2 = z, nb = z;
  if (idx < TR * 128) loaditem(idx, n0, n1, n2, nb);
  for (; idx < TR * 128; idx += stride) {
    const u32x4 c0 = n0, c1 = n1, c2 = n2, bg = nb;
    if (idx + stride < TR * 128) loaditem(idx + stride, n0, n1, n2, nb);
    u32x4 o;
#pragma unroll
    for (int q = 0; q < 4; ++q) {
      const float lo = bflo(bg[q]) * (w0[2 * q] * bflo(c0[q]) + w1[2 * q] * bflo(c1[q]) + w2[2 * q] * bflo(c2[q]));
      const float hi = bfhi(bg[q]) * (w0[2 * q + 1] * bfhi(c0[q]) + w1[2 * q + 1] * bfhi(c1[q]) + w2[2 * q + 1] * bfhi(c2[q]));
      o[q] = pk2(lo, hi);
    }
    *(u32x4*)(cB + (size_t)(idx >> 7) * 1024 + ch) = o;
  }
}

constexpr int ML_QS = 0, ML_KS = 8704, ML_KW = 17408, ML_VT = 26624, ML_CT = 30080, ML_VEC_B = 73216;
__device__ void mlstm_run(const Params& P, int wg, char* smc) {
  bf16_t* sm = (bf16_t*)smc;
  bf16_t* Qs = sm + ML_QS; bf16_t* Ks = sm + ML_KS; bf16_t* KWt = sm + ML_KW; bf16_t* Vt = sm + ML_VT; bf16_t* Ct = sm + ML_CT; bf16_t* Ps = Ks;
  float* Arow = (float*)(smc + ML_VEC_B); float* Bcol = Arow + 64; float* avec = Bcol + 64; float* wkv = avec + 64; float* eFs = wkv + 64;
  const int tid = otid(), lane = tid & 63, w = tid >> 6, lr = lane & 15, g = lane >> 4;
  const int slice = wg & 7, dir = (wg >> 3) & 1, h = (wg >> 4) & 3, b = wg >> 6, v0 = slice * 32;
  const bf16_t* mq = slot(P, 3); const bf16_t* mk = mq + (size_t)TR * 512; const bf16_t* mkT = slot(P, 4); const bf16_t* mvT = slot(P, 5);
  const float* G = (const float*)(P.ws + OFF_GATES);
  bf16_t* hdir = slot(P, dir == 0 ? 1 : 0);
  __syncthreads();
  for (int idx = tid; idx < 16 * LDT; idx += 256) Vt[32 * LDT + idx] = (idx < LDT) ? (bf16_t)0x3F80 : (bf16_t)0;
  f32x4 Cacc[2][3];
#pragma unroll
  for (int a = 0; a < 2; ++a)
#pragma unroll
    for (int n = 0; n < 3; ++n) Cacc[a][n] = (f32x4){0.f, 0.f, 0.f, 0.f};
  u32x4 rq[4], rk[4], rkt[4], rvt; float gi = 0.f, gf = 0.f;
  const int qs_r = tid >> 4, qs_c = (tid & 15) * 8;
  const int kt_d = tid >> 3, kt_s = (tid & 7) * 8;
  auto chunk_p0 = [&](int n) { const int c = (dir == 0) ? n : (n < 4 ? 3 - n : 135 - n); return c * 64; };
  auto prefetch = [&](int n) {
    const int p0 = chunk_p0(n); const size_t R0 = (size_t)b * PB + p0;
#pragma unroll
    for (int i = 0; i < 4; ++i) {
      rq[i] = *(const u32x4*)(mq + (R0 + qs_r + 16 * i) * 512 + h * 128 + qs_c);
      rk[i] = *(const u32x4*)(mk + (R0 + qs_r + 16 * i) * 512 + h * 128 + qs_c);
      rkt[i] = *(const u32x4*)(mkT + (size_t)(b * 512 + h * 128 + kt_d + 32 * i) * PB + p0 + kt_s);
    }
    rvt = *(const u32x4*)(mvT + (size_t)(b * 1024 + h * 256 + v0 + kt_d) * PB + p0 + kt_s);
    if (tid < 64) { gi = G[(R0 + tid) * 16 + dir * 8 + h]; gf = G[(R0 + tid) * 16 + dir * 8 + 4 + h]; }
  };
  prefetch(0);
  for (int n = 0; n < 132; ++n) {
    const int p0 = chunk_p0(n); const size_t R0 = (size_t)b * PB + p0;
    __syncthreads();
#pragma unroll
    for (int i = 0; i < 4; ++i) { *(u32x4*)(Qs + (qs_r + 16 * i) * 136 + qs_c) = rq[i]; *(u32x4*)(Ks + (qs_r + 16 * i) * 136 + qs_c) = rk[i]; }
    *(u32x4*)(Vt + kt_d * LDT + kt_s) = rvt;
#pragma unroll
    for (int a = 0; a < 2; ++a)
#pragma unroll
      for (int nv = 0; nv < 3; ++nv) { u32x2 o; o.x = pk2(Cacc[a][nv][0], Cacc[a][nv][1]); o.y = pk2(Cacc[a][nv][2], Cacc[a][nv][3]);
        *(u32x2*)(Ct + (16 * nv + lr) * 136 + 16 * (2 * w + a) + 4 * g) = o; }
    if (w == 0) {
      const float lf = fminf(gf, 0.f) - __logf(1.f + __expf(-fabsf(gf)));
      float bc = lf;
#pragma unroll
      for (int off = 1; off < 64; off <<= 1) {
        const float o = shl_(bc, ((dir == 0) ? lane - off : lane + off) & 63);
        const bool ok = (dir == 0) ? (lane >= off) : (lane + off < 64);
        if (ok) bc += o;
      }
      const float Ftot = shl_(bc, dir == 0 ? 63 : 0);
      Arow[lane] = bc; Bcol[lane] = gi - bc; avec[lane] = __expf(bc); wkv[lane] = __expf(Ftot - bc + gi);
      if (lane == 0) eFs[0] = __expf(Ftot);
    }
    __syncthreads();
    {
      const f32x4 wa = *(const f32x4*)(wkv + kt_s), wb = *(const f32x4*)(wkv + kt_s + 4);
#pragma unroll
      for (int i = 0; i < 4; ++i) {
        u32x4 o;
        o.x = pk2(bflo(rkt[i].x) * wa[0], bfhi(rkt[i].x) * wa[1]); o.y = pk2(bflo(rkt[i].y) * wa[2], bfhi(rkt[i].y) * wa[3]);
        o.z = pk2(bflo(rkt[i].z) * wb[0], bfhi(rkt[i].z) * wb[1]); o.w = pk2(bflo(rkt[i].w) * wb[2], bfhi(rkt[i].w) * wb[3]);
        *(u32x4*)(KWt + (kt_d + 32 * i) * LDT + kt_s) = o;
      }
    }
    s16x8 qf[4];
#pragma unroll
    for (int ks = 0; ks < 4; ++ks) qf[ks] = *(const s16x8*)(Qs + (16 * w + lr) * 136 + 32 * ks + 8 * g);
    f32x4 sT[4];
#pragma unroll
    for (int st = 0; st < 4; ++st) {
      sT[st] = (f32x4){0.f, 0.f, 0.f, 0.f};
#pragma unroll
      for (int ks = 0; ks < 4; ++ks) { const s16x8 kf = *(const s16x8*)(Ks + (16 * st + lr) * 136 + 32 * ks + 8 * g); sT[st] = __builtin_amdgcn_mfma_f32_16x16x32_bf16(kf, qf[ks], sT[st], 0, 0, 0); }
    }
    {
      const int t = 16 * w + lr; const float ar = Arow[t];
#pragma unroll
      for (int st = 0; st < 4; ++st) {
        const f32x4 bc4 = *(const f32x4*)(Bcol + 16 * st + 4 * g);
#pragma unroll
        for (int i = 0; i < 4; ++i) {
          const int s = 16 * st + 4 * g + i;
          const bool ok = (dir == 0) ? (s <= t) : (s >= t);
          sT[st][i] = ok ? sT[st][i] * __expf(ar + bc4[i]) : 0.f;
        }
      }
    }
    __syncthreads();
    if (n + 1 < 132) prefetch(n + 1);
    s16x8 vf[3][2];
#pragma unroll
    for (int nv = 0; nv < 3; ++nv)
#pragma unroll
      for (int sg = 0; sg < 2; ++sg) {
        const u32x2 lo = *(const u32x2*)(Vt + (16 * nv + lr) * LDT + 32 * sg + 4 * g), hi = *(const u32x2*)(Vt + (16 * nv + lr) * LDT + 32 * sg + 16 + 4 * g);
        u32x4 vv; vv.x = lo.x; vv.y = lo.y; vv.z = hi.x; vv.w = hi.y; vf[nv][sg] = __builtin_bit_cast(s16x8, vv);
      }
    f32x4 hI[3], hC[3];
#pragma unroll
    for (int nv = 0; nv < 3; ++nv) { hI[nv] = (f32x4){0.f, 0.f, 0.f, 0.f}; hC[nv] = (f32x4){0.f, 0.f, 0.f, 0.f}; }
#pragma unroll
    for (int sg = 0; sg < 2; ++sg) {
      u32x4 pk; pk.x = pk2(sT[2 * sg][0], sT[2 * sg][1]); pk.y = pk2(sT[2 * sg][2], sT[2 * sg][3]); pk.z = pk2(sT[2 * sg + 1][0], sT[2 * sg + 1][1]); pk.w = pk2(sT[2 * sg + 1][2], sT[2 * sg + 1][3]);
      const s16x8 pf = __builtin_bit_cast(s16x8, pk);
#pragma unroll
      for (int nv = 0; nv < 3; ++nv) hI[nv] = __builtin_amdgcn_mfma_f32_16x16x32_bf16(pf, vf[nv][sg], hI[nv], 0, 0, 0);
    }
#pragma unroll
    for (int ks = 0; ks < 4; ++ks)
#pragma unroll
      for (int nv = 0; nv < 3; ++nv) { const s16x8 cf = *(const s16x8*)(Ct + (16 * nv + lr) * 136 + 32 * ks + 8 * g); hC[nv] = __builtin_amdgcn_mfma_f32_16x16x32_bf16(qf[ks], cf, hC[nv], 0, 0, 0); }
    {
      const f32x4 av4 = *(const f32x4*)(avec + 16 * w + 4 * g);
#pragma unroll
      for (int i = 0; i < 4; ++i) {
        const float den = hI[2][i] + av4[i] * hC[2][i];
        const float dn = shl_(den, lane & 48);
        const float inv = 1.f / fmaxf(fabsf(dn), 1.f);
#pragma unroll
        for (int nv = 0; nv < 2; ++nv) hdir[(R0 + 16 * w + 4 * g + i) * 1024 + h * 256 + v0 + 16 * nv + lr] = f2bf((hI[nv][i] + av4[i] * hC[nv][i]) * inv);
      }
    }
    {
      const float ef = eFs[0];
#pragma unroll
      for (int a = 0; a < 2; ++a) {
#pragma unroll
        for (int nv = 0; nv < 3; ++nv) Cacc[a][nv] = Cacc[a][nv] * ef;
#pragma unroll
        for (int sg = 0; sg < 2; ++sg) {
          const u32x2 klo = *(const u32x2*)(KWt + (16 * (2 * w + a) + lr) * LDT + 32 * sg + 4 * g), khi = *(const u32x2*)(KWt + (16 * (2 * w + a) + lr) * LDT + 32 * sg + 16 + 4 * g);
          u32x4 kk; kk.x = klo.x; kk.y = klo.y; kk.z = khi.x; kk.w = khi.y; const s16x8 kw = __builtin_bit_cast(s16x8, kk);
#pragma unroll
          for (int nv = 0; nv < 3; ++nv) Cacc[a][nv] = __builtin_amdgcn_mfma_f32_16x16x32_bf16(kw, vf[nv][sg], Cacc[a][nv], 0, 0, 0);
        }
      }
    }
  }
}

#define YA_DST(P, l) slot(P, 7)
__device__ void attn_unit(const Params& P, int layer_, int u, int half, char* smc) {
  constexpr int LDV = 68;
  bf16_t* Ksm = (bf16_t*)smc;
  bf16_t* Vsm = Ksm + 64 * 136;
  const int tid = otid(), lane = tid & 63, w = tid >> 6, r = lane & 31, h = lane >> 5;
  int b, head, pq0, nkeys;
  if (u < 1024) { b = u >> 9; head = (u >> 6) & 7; pq0 = NCTX + 128 * (u & 63); nkeys = PB; }
  else { const int v = u - 1024; b = v >> 4; head = (v >> 1) & 7; pq0 = 128 * (v & 1); nkeys = NCTX; }
  const int kvh = head >> 2;
  const int kbeg = half > 0 ? half * (PB / 4) : 0, kend = half >= 0 ? (half + 1) * (PB / 4) : nkeys;
  bf16_t* aq = slot(P, 7);
  const bf16_t* ak = slot(P, 4) + (size_t)TR * 512; const bf16_t* avT = ak + (size_t)TR * 256;
  constexpr int ABUF = 64 * 136 + 128 * LDV;
  s16x8 qf[8];
#pragma unroll
  for (int ks = 0; ks < 8; ++ks) qf[ks] = *(const s16x8*)(aq + (size_t)(b * PB + pq0 + 32 * w + r) * 1024 + head * 128 + 16 * ks + 8 * h);
  f32x16 O[4];
#pragma unroll
  for (int d = 0; d < 4; ++d)
#pragma unroll
    for (int e = 0; e < 16; ++e) O[d][e] = 0.f;
  float mrun = 0.f, lrun = 0.f;
  f32x16 cinit;
#pragma unroll
  for (int e = 0; e < 16; ++e) cinit[e] = 0.f;
  const int k_r = tid >> 4, k_c = (tid & 15) * 8, v_d = tid >> 3, v_c = (tid & 7) * 8;
  const bf16_t* kp = ak + (size_t)(b * PB + kbeg + k_r) * 256 + kvh * 128 + k_c;
  const bf16_t* vp = avT + (size_t)(b * 256 + kvh * 128 + v_d) * PB + kbeg + v_c;
  const int nkt = kend - kbeg;
  u32x4 rk[4], rv[4];
  auto stage = [&](bf16_t* Kd, bf16_t* Vd) {
#pragma unroll
    for (int i = 0; i < 4; ++i) {
      *(u32x4*)(Kd + (k_r + 16 * i) * 136 + k_c) = rk[i];
      u32x2 lo, hi; lo.x = rv[i].x; lo.y = rv[i].y; hi.x = rv[i].z; hi.y = rv[i].w;
      *(u32x2*)(Vd + (v_d + 32 * i) * LDV + v_c) = lo; *(u32x2*)(Vd + (v_d + 32 * i) * LDV + v_c + 4) = hi;
    }
  };
#pragma unroll
  for (int i = 0; i < 4; ++i) { rk[i] = *(const u32x4*)(kp + (size_t)(16 * i) * 256); rv[i] = *(const u32x4*)(vp + (size_t)(32 * i) * PB); }
  __syncthreads();
  stage(Ksm, Vsm);
  if (64 < nkt) {
#pragma unroll
    for (int i = 0; i < 4; ++i) { rk[i] = *(const u32x4*)(kp + (size_t)(64 + 16 * i) * 256); rv[i] = *(const u32x4*)(vp + (size_t)(32 * i) * PB + 64); }
  }
  __syncthreads();
  for (int k0 = 0; k0 < nkt; k0 += 64) {
    const int cb = (k0 >> 6) & 1;
    const bf16_t* Kc = Ksm + cb * ABUF; const bf16_t* Vc = Vsm + cb * ABUF;
    if (k0 + 64 < nkt) {
      stage(Ksm + (cb ^ 1) * ABUF, Vsm + (cb ^ 1) * ABUF);
      if (k0 + 128 < nkt) {
#pragma unroll
        for (int i = 0; i < 4; ++i) { rk[i] = *(const u32x4*)(kp + (size_t)(k0 + 128 + 16 * i) * 256); rv[i] = *(const u32x4*)(vp + (size_t)(32 * i) * PB + k0 + 128); }
      }
    }
    f32x16 S[2];
#pragma unroll
    for (int ks = 0; ks < 8; ++ks)
#pragma unroll
      for (int m = 0; m < 2; ++m) {
        const s16x8 kf = *(const s16x8*)(Kc + (32 * m + r) * 136 + 16 * ks + 8 * h);
        S[m] = __builtin_amdgcn_mfma_f32_32x32x16_bf16(kf, qf[ks], ks == 0 ? cinit : S[m], 0, 0, 0);
      }
    __builtin_amdgcn_sched_barrier(0);
    float mx = -1e30f;
#pragma unroll
    for (int m = 0; m < 2; ++m)
#pragma unroll
      for (int e = 0; e < 16; ++e) mx = fmaxf(mx, S[m][e]);
    mx = fmaxf(mx, shx(mx, 32, lane));
    if (__builtin_amdgcn_ballot_w64(mx > 8.f) != 0ull) {
      const float dlt = fmaxf(mx, 0.f), alpha = __builtin_amdgcn_exp2f(-dlt);
      mrun += dlt; lrun *= alpha;
#pragma unroll
      for (int d = 0; d < 4; ++d) O[d] = O[d] * alpha;
#pragma unroll
      for (int m = 0; m < 2; ++m)
#pragma unroll
        for (int e = 0; e < 16; ++e) S[m][e] -= dlt;
#pragma unroll
      for (int e = 0; e < 16; ++e) cinit[e] = -mrun;
    }
    float ls = 0.f;
#pragma unroll
    for (int m = 0; m < 2; ++m)
#pragma unroll
      for (int e = 0; e < 16; ++e) { const float pv = __builtin_amdgcn_exp2f(S[m][e]); S[m][e] = pv; ls += pv; }
    lrun += ls;
    s16x8 pf[2][2];
#pragma unroll
    for (int m = 0; m < 2; ++m)
#pragma unroll
      for (int sg = 0; sg < 2; ++sg) {
        u32x4 pk; pk.x = pk2(S[m][8 * sg + 0], S[m][8 * sg + 1]); pk.y = pk2(S[m][8 * sg + 2], S[m][8 * sg + 3]);
        pk.z = pk2(S[m][8 * sg + 4], S[m][8 * sg + 5]); pk.w = pk2(S[m][8 * sg + 6], S[m][8 * sg + 7]);
        pf[m][sg] = __builtin_bit_cast(s16x8, pk);
      }
    __builtin_amdgcn_sched_barrier(0);
#pragma unroll
    for (int m = 0; m < 2; ++m)
#pragma unroll
      for (int sg = 0; sg < 2; ++sg)
#pragma unroll
        for (int d = 0; d < 4; ++d) {
          const u32x2 lo = *(const u32x2*)(Vc + (32 * d + r) * LDV + 32 * m + 16 * sg + 4 * h);
          const u32x2 hi = *(const u32x2*)(Vc + (32 * d + r) * LDV + 32 * m + 16 * sg + 8 + 4 * h);
          u32x4 vv; vv.x = lo.x; vv.y = lo.y; vv.z = hi.x; vv.w = hi.y;
          O[d] = __builtin_amdgcn_mfma_f32_32x32x16_bf16(__builtin_bit_cast(s16x8, vv), pf[m][sg], O[d], 0, 0, 0);
        }
    __syncthreads();
  }
  {
    float l = lrun; l += shx(l, 32, lane);
    const float inv = 1.f / l;
    const int rrow = 32 * w + r;
    bf16_t* op = YA_DST(P, layer_) + (size_t)(b * PB + pq0 + rrow) * 1024 + head * 128 + 4 * h;
    if (half >= 0) {
      const int su = u - 896;
      op = (bf16_t*)(P.ws + OFF_PO) + ((size_t)(half * 128 + su) * 128 + rrow) * 128 + 4 * h;
      if (h == 0) ((f32x2*)(P.ws + OFF_ML))[(size_t)(half * 128 + su) * 128 + rrow] = (f32x2){mrun, l};
    }
#pragma unroll
    for (int d = 0; d < 4; ++d)
#pragma unroll
      for (int q = 0; q < 4; ++q) { u32x2 o; o.x = pk2(O[d][4 * q] * inv, O[d][4 * q + 1] * inv); o.y = pk2(O[d][4 * q + 2] * inv, O[d][4 * q + 3] * inv); *(u32x2*)(op + 32 * d + 8 * q) = o; }
  }
}

__device__ void phase_mix(const Params& P, int layer, char* smc) {
  for (int wg = blockIdx.x; wg < 128; wg += gridDim.x) mlstm_run(P, wg, smc);
  unsigned* cnt = (unsigned*)(P.ws + OFF_CNT) + layer;
  int* ubox = (int*)(smc + 74496);
  const int NUX = 896 + 512 + ((layer == 0) ? 32 : 0);
  for (;;) {
    __syncthreads();
    if (otid() == 0) ubox[0] = (int)atomicAdd(cnt, 1u);
    __syncthreads();
    const int it = ubox[0];
    if (it >= NUX) break;
    if (it < 896) attn_unit(P, layer, it, -1, smc);
    else if (it < 1408) attn_unit(P, layer, 896 + ((it - 896) >> 2), (it - 896) & 3, smc);
    else attn_unit(P, layer, 1024 + (it - 1408), -1, smc);
  }
}

__device__ void phase_fin(const Params& P, int layer) {
  const int tid = otid(), lane = tid & 63, w = tid >> 6;
  bf16_t* hf = slot(P, 1); const bf16_t* hb = slot(P, 0); const bf16_t* mo = slot(P, 6); bf16_t* h1n = slot(P, 3);
  const float* gain = P.mnorm + layer * 1024; const float* gvec = P.norm1 + layer * 1024;
  for (int R = blockIdx.x * 4 + w; R < TR; R += gridDim.x * 4) {
    const int b = R / PB, p = R - b * PB;
    if (layer == 1 && p < NCTX) continue;
    const int col = lane * 16;
    u32x4 ha[2], hc[2], og[2]; f32x4 gn[4];
#pragma unroll
    for (int q = 0; q < 2; ++q) { ha[q] = *(const u32x4*)(hf + (size_t)R * 1024 + col + 8 * q); hc[q] = *(const u32x4*)(hb + (size_t)R * 1024 + col + 8 * q); og[q] = *(const u32x4*)(mo + (size_t)R * 1024 + col + 8 * q); }
#pragma unroll
    for (int q = 0; q < 4; ++q) gn[q] = *(const f32x4*)(gain + col + 4 * q);
    const float* xr = xsrc_row(P, layer == 0, R);
    const float* mod = (const float*)(P.ws + OFF_MOD) + (size_t)(layer * 3 + (p < NCTX ? 2 : b)) * 6144;
    f32x4 xv[4], gv4[4], sh4[4], sc4[4];
#pragma unroll
    for (int i = 0; i < 4; ++i) { const int c4 = 256 * i + lane * 4; xv[i] = *(const f32x4*)(xr + c4); gv4[i] = *(const f32x4*)(gvec + c4); sh4[i] = *(const f32x4*)(mod + c4); sc4[i] = *(const f32x4*)(mod + 1024 + c4); }
    const bool split = (b == 1 && p >= NCTX && lane < 32);
    f32x2 ml[4]; u32x4 pa[4];
    if (split) {
      const int sl = p - NCTX, qb = sl >> 7, r = sl & 127, hd = lane >> 4, su = hd * 64 + qb;
      const f32x2* mlp = (const f32x2*)(P.ws + OFF_ML); const bf16_t* po = (const bf16_t*)(P.ws + OFF_PO);
#pragma unroll
      for (int q = 0; q < 4; ++q) { ml[q] = mlp[(size_t)(q * 128 + su) * 128 + r]; pa[q] = *(const u32x4*)(po + ((size_t)(q * 128 + su) * 128 + r) * 128 + (lane & 15) * 8); }
    }
    float v[16]; float ss = 0.f;
#pragma unroll
    for (int q = 0; q < 2; ++q)
#pragma unroll
      for (int e = 0; e < 4; ++e) { v[8 * q + 2 * e] = bflo(ha[q][e]) + bflo(hc[q][e]); v[8 * q + 2 * e + 1] = bfhi(ha[q][e]) + bfhi(hc[q][e]); }
#pragma unroll
    for (int e = 0; e < 16; ++e) ss += v[e] * v[e];
    ss += shx(ss, 1, lane); ss += shx(ss, 2, lane); ss += shx(ss, 4, lane); ss += shx(ss, 8, lane);
    const float rstd = rsqrtf(ss * (1.f / 256.f) + EPS);
    u32x4 ym[2];
#pragma unroll
    for (int q = 0; q < 2; ++q)
#pragma unroll
      for (int e = 0; e < 4; ++e) {
        const float lo = v[8 * q + 2 * e] * rstd * gn[2 * q + (e >> 1)][(2 * e) & 3] * sigmoidf_(bflo(og[q][e]));
        const float hi = v[8 * q + 2 * e + 1] * rstd * gn[2 * q + (e >> 1)][(2 * e + 1) & 3] * sigmoidf_(bfhi(og[q][e]));
        ym[q][e] = pk2(lo, hi);
      }
    float s2 = 0.f;
#pragma unroll
    for (int i = 0; i < 4; ++i) s2 += xv[i][0] * xv[i][0] + xv[i][1] * xv[i][1] + xv[i][2] * xv[i][2] + xv[i][3] * xv[i][3];
#pragma unroll
    for (int o = 32; o >= 1; o >>= 1) s2 += shx(s2, o, lane);
    const float rstd2 = rsqrtf(s2 * (1.f / 1024.f) + EPS);
    u32x2 hq[4];
#pragma unroll
    for (int i = 0; i < 4; ++i) {
#pragma unroll
      for (int e = 0; e < 4; ++e) xv[i][e] = (xv[i][e] * rstd2 * gv4[i][e]) * (1.f + sc4[i][e]) + sh4[i][e];
      hq[i].x = pk2(xv[i][0], xv[i][1]); hq[i].y = pk2(xv[i][2], xv[i][3]);
    }
#pragma unroll
    for (int q = 0; q < 2; ++q) *(u32x4*)(hf + (size_t)R * 1024 + col + 8 * q) = ym[q];
#pragma unroll
    for (int i = 0; i < 4; ++i) *(u32x2*)(h1n + (size_t)R * 1024 + 256 * i + lane * 4) = hq[i];
    if (split) {
      float mm = -1e30f;
#pragma unroll
      for (int q = 0; q < 4; ++q) mm = fmaxf(mm, ml[q].x);
      float wq[4], ws_ = 0.f;
#pragma unroll
      for (int q = 0; q < 4; ++q) { wq[q] = ml[q].y * __builtin_amdgcn_exp2f(ml[q].x - mm); ws_ += wq[q]; }
      const float inv = 1.f / ws_;
      float o8[8];
#pragma unroll
      for (int e = 0; e < 8; ++e) o8[e] = 0.f;
#pragma unroll
      for (int q = 0; q < 4; ++q) {
        const float wv = wq[q] * inv;
#pragma unroll
        for (int e = 0; e < 4; ++e) { o8[2 * e] += bflo(pa[q][e]) * wv; o8[2 * e + 1] += bfhi(pa[q][e]) * wv; }
      }
      u32x4 o;
#pragma unroll
      for (int e = 0; e < 4; ++e) o[e] = pk2(o8[2 * e], o8[2 * e + 1]);
      *(u32x4*)(YA_DST(P, layer) + (size_t)R * 1024 + 768 + lane * 8) = o;
    }
  }
}

template <int MW, int NT>
__device__ __forceinline__ void merge_tile(const Params& P, int layer, int R0, int nt_, bf16_t* sm) {
  const int tid = otid(), lane = tid & 63, w = tid >> 6, r = lane & 31, h = lane >> 5;
  constexpr int NQ = NT / 2, LDW = 16 * NT + 8;
  const bf16_t* h1n = slot(P, 3); bf16_t* merged = slot(P, 4);
  f32x16 mer[MW / 2][NQ]; zero_acc<MW, NT>(mer);
#pragma unroll 1
  for (int br = 0; br < 3; ++br) {
    f32x16 ga[MW / 2][NQ]; zero_acc<MW, NT>(ga);
    gemm_core<MW, NT>(h1n + (size_t)R0 * 1024, 1024, wbuf(P, W_IN) + (size_t)(7680 + 1024 * br + 16 * NT * nt_) * 1024, 1024, 1024, ga, sm);
    unsigned gp[MW / 2][NQ][8];
#pragma unroll
    for (int m = 0; m < MW / 2; ++m)
#pragma unroll
      for (int n = 0; n < NQ; ++n)
#pragma unroll
        for (int k = 0; k < 8; ++k) gp[m][n][k] = pk2(sigmoidf_(ga[m][n][2 * k]), sigmoidf_(ga[m][n][2 * k + 1]));
    f32x16 ya[MW / 2][NQ]; zero_acc<MW, NT>(ya);
    const bf16_t* yb = br == 1 ? YA_DST(P, layer) : slot(P, br == 0 ? 1 : 2);
    gemm_core<MW, NT>(yb + (size_t)R0 * 1024, 1024, wbuf(P, W_PM + (size_t)br * 2097152) + (size_t)(16 * NT * nt_) * 1024, 1024, 1024, ya, sm);
#pragma unroll
    for (int m = 0; m < MW / 2; ++m)
#pragma unroll
      for (int n = 0; n < NQ; ++n)
#pragma unroll
        for (int k = 0; k < 8; ++k) { mer[m][n][2 * k] += bflo(gp[m][n][k]) * ya[m][n][2 * k]; mer[m][n][2 * k + 1] += bfhi(gp[m][n][k]) * ya[m][n][2 * k + 1]; }
  }
  bf16_t* smw = sm + w * 32 * LDW;
#pragma unroll
  for (int m = 0; m < MW / 2; ++m) {
#pragma unroll
    for (int q = 0; q < 4; ++q)
#pragma unroll
      for (int i = 0; i < 4; ++i)
#pragma unroll
        for (int n = 0; n < NQ; ++n) smw[(8 * q + 4 * h + i) * LDW + 32 * n + r] = f2bf(mer[m][n][4 * q + i]);
    flush_pass<NT>(smw, merged + (size_t)(R0 + 16 * MW * w + 32 * m) * 1024 + 16 * NT * nt_, 1024, lane);
  }
}
__device__ void phase_merge(const Params& P, int layer, char* smc) {
  bf16_t* sm = (bf16_t*)smc;
  const int x = blockIdx.x & 7, loc = blockIdx.x >> 3, nloc = gridDim.x >> 3;
  for (int j = loc; j < 128; j += nloc) {
    const int jl = j & 63, mt = 16 * x + 8 * (j >> 6) + ((jl >> 1) & 7), nt = (jl & 1) | ((jl >> 4) << 1);
    merge_tile<2, 8>(P, layer, (mt >> 6) * PB + NCTX + (mt & 63) * 128, nt, sm);
  }
  if (layer == 0)
    for (int k = loc;; k += nloc) { const int sidx = x + 8 * k; if (sidx >= 64) break; merge_tile<2, 4>(P, layer, small_R0(sidx >> 4), sidx & 15, sm); }
}

template <int MW>
__device__ __forceinline__ void resid_tile(const Params& P, int layer, const bf16_t* A, int lda, int K, const bf16_t* Wt, int modchunk, bool srcInput, int R0, int nt_, bf16_t* sm, int kofs = 0, int klen = 0) {
  const int tid = otid(), lane = tid & 63, w = tid >> 6, r = lane & 31, h = lane >> 5;
  f32x16 acc[MW / 2][4]; zero_acc<MW, 8>(acc);
  gemm_core<MW, 8>(A + (size_t)R0 * lda + kofs, lda, Wt + (size_t)nt_ * 128 * K + kofs, K, klen ? klen : K, acc, sm);
  const float* gate = modrow(P, layer, R0) + modchunk * 1024 + nt_ * 128;
  float gv[4];
#pragma unroll
  for (int n = 0; n < 4; ++n) gv[n] = gate[32 * n + r];
  if (klen) {
#pragma unroll
    for (int m = 0; m < MW / 2; ++m)
#pragma unroll
      for (int q = 0; q < 4; ++q)
#pragma unroll
        for (int i = 0; i < 4; ++i) {
          float* xd = xdst_row(P, R0 + 16 * MW * w + 32 * m + 8 * q + 4 * h + i) + nt_ * 128;
#pragma unroll
          for (int n = 0; n < 4; ++n) atomicAdd(xd + 32 * n + r, gv[n] * acc[m][n][4 * q + i]);
        }
    return;
  }
  constexpr int NR = 8 * MW;
  float xin[2][4];
  {
    const float* xs = xsrc_row(P, srcInput, R0 + 16 * MW * w + 4 * h) + nt_ * 128;
#pragma unroll
    for (int n = 0; n < 4; ++n) xin[0][n] = xs[32 * n + r];
  }
#pragma unroll
  for (int j = 0; j < NR; ++j) {
    const int m = j >> 4, q = (j >> 2) & 3, i = j & 3;
    const int R = R0 + 16 * MW * w + 32 * m + 8 * q + 4 * h + i;
    if (j + 1 < NR) {
      const int jn = j + 1, Rn = R0 + 16 * MW * w + 32 * (jn >> 4) + 8 * ((jn >> 2) & 3) + 4 * h + (jn & 3);
      const float* xs = xsrc_row(P, srcInput, Rn) + nt_ * 128;
#pragma unroll
      for (int n = 0; n < 4; ++n) xin[(j + 1) & 1][n] = xs[32 * n + r];
    }
    float* xd = xdst_row(P, R) + nt_ * 128;
#pragma unroll
    for (int n = 0; n < 4; ++n) xd[32 * n + r] = xin[j & 1][n] + gv[n] * acc[m][n][4 * q + i];
  }
}
__device__ void phase_resid(const Params& P, int layer, const bf16_t* A, int lda, int K, const bf16_t* Wt, int modchunk, bool srcInput, char* smc) {
  bf16_t* sm = (bf16_t*)smc;
  const int x = blockIdx.x & 7, loc = blockIdx.x >> 3, nloc = gridDim.x >> 3, nks = K >> 7;
  for (int j = loc; j < 64; j += nloc) resid_tile<4>(P, layer, A, lda, K, Wt, modchunk, srcInput, big_R0(8 * x + ((j >> 1) & 7)), (j & 1) | ((j >> 4) << 1), sm);
  if (layer == 0)
    for (int q = blockIdx.x; q < 32 * nks; q += gridDim.x) { const int t = q / nks, ks = q - t * nks; resid_tile<2>(P, layer, A, lda, K, Wt, modchunk, false, small_R0(t >> 3), t & 7, sm, ks * 128, 128); }
}

template <int MW>
__device__ __forceinline__ void up_tile(const Params& P, int R0, int nt_, bf16_t* sm) {
  const int tid = otid(), lane = tid & 63, w = tid >> 6, r = lane & 31, h = lane >> 5;
  const bf16_t* h2 = slot(P, 0); bf16_t* U = slot(P, 3);
  f32x16 acc[MW / 2][4]; zero_acc<MW, 8>(acc);
  gemm_core<MW, 8>(h2 + (size_t)R0 * 1024, 1024, wbuf(P, W_UP) + (size_t)nt_ * 128 * 1024, 1024, 1024, acc, sm);
  bf16_t* smw = sm + w * 32 * 136;
#pragma unroll
  for (int m = 0; m < MW / 2; ++m) {
#pragma unroll
    for (int q = 0; q < 4; ++q)
#pragma unroll
      for (int i = 0; i < 4; ++i)
#pragma unroll
        for (int n = 0; n < 4; ++n) { const float v = fmaxf(acc[m][n][4 * q + i], 0.f); smw[(8 * q + 4 * h + i) * 136 + 32 * n + r] = f2bf(v * v); }
    flush_pass<8>(smw, U + (size_t)(R0 + 16 * MW * w + 32 * m) * 4096 + nt_ * 128, 4096, lane);
  }
}
__device__ void phase_up(const Params& P, int layer, char* smc) {
  bf16_t* sm = (bf16_t*)smc;
  for (int i = 0;; ++i) {
    bool big; int R0, nt;
    if (!gemm_unit(i, 32, layer == 0, big, R0, nt)) break;
    if (big) up_tile<4>(P, R0, nt, sm); else up_tile<2>(P, R0, nt, sm);
  }
}

__device__ void phase_fnorm(const Params& P) {
  const int tid = otid(), lane = tid & 63, w = tid >> 6;
  const int rstride = gridDim.x * 4;
  f32x4 xn[4], gfn[4];
#pragma unroll
  for (int i = 0; i < 4; ++i) gfn[i] = *(const f32x4*)(P.fnorm + 256 * i + lane * 4);
  int r = blockIdx.x * 4 + w;
  if (r < 2 * SEQ) {
#pragma unroll
    for (int i = 0; i < 4; ++i) xn[i] = *(const f32x4*)(P.out + (size_t)r * 1024 + 256 * i + lane * 4);
  }
  for (; r < 2 * SEQ; r += rstride) {
    float* xr = P.out + (size_t)r * 1024;
    f32x4 xv[4]; float ss = 0.f;
#pragma unroll
    for (int i = 0; i < 4; ++i) { xv[i] = xn[i]; ss += xv[i][0] * xv[i][0] + xv[i][1] * xv[i][1] + xv[i][2] * xv[i][2] + xv[i][3] * xv[i][3]; }
    if (r + rstride < 2 * SEQ) {
#pragma unroll
      for (int i = 0; i < 4; ++i) xn[i] = *(const f32x4*)(P.out + (size_t)(r + rstride) * 1024 + 256 * i + lane * 4);
    }
#pragma unroll
    for (int o = 32; o >= 1; o >>= 1) ss += shx(ss, o, lane);
    const float rstd = rsqrtf(ss * (1.f / 1024.f) + EPS);
#pragma unroll
    for (int i = 0; i < 4; ++i) { f32x4 o;
#pragma unroll
      for (int e = 0; e < 4; ++e) o[e] = xv[i][e] * rstd * gfn[i][e];
      *(f32x4*)(xr + 256 * i + lane * 4) = o; }
  }
}

constexpr int LDS_BYTES = 74752;
constexpr int NPHASE = 22;
__device__ void run_phase(const Params& P, int ph, char* sm) {
  if (ph == 0) { phase_prologue(P, sm); return; }
  if (ph == 21) { phase_fnorm(P); return; }
  const int layer = (ph - 1) / 10, k = (ph - 1) % 10;
  switch (k) {
    case 0: phase_norm(P, layer, 0, sm); break;
    case 1: phase_inproj(P, layer, sm); break;
    case 2: phase_conv(P, layer); break;
    case 3: phase_mix(P, layer, sm); break;
    case 4: phase_fin(P, layer); break;
    case 5: phase_merge(P, layer, sm); break;
    case 6: phase_resid(P, layer, slot(P, 4), 1024, 1024, wbuf(P, W_O), 2, layer == 0, sm); break;
    case 7: phase_norm(P, layer, 1, sm); break;
    case 8: phase_up(P, layer, sm); break;
    default: phase_resid(P, layer, slot(P, 3), 4096, 4096, wbuf(P, W_DN), 5, false, sm); break;
  }
}

__device__ __forceinline__ void grid_barrier(char* ws, unsigned gen) {
  asm volatile("s_waitcnt vmcnt(0)" ::: "memory");
  __syncthreads();
  unsigned* flags = (unsigned*)(ws + OFF_CNT + 1024); unsigned* rel = (unsigned*)(ws + OFF_CNT + 3584);
  const int tid = otid();
  if (tid < 64) {
    __builtin_amdgcn_fence(__ATOMIC_RELEASE, "agent");
    if (blockIdx.x == 0) {
      for (;;) {
        bool ok = true;
#pragma unroll
        for (int j = 0; j < 8; ++j) { const int idx = tid + 64 * j; if (idx != 0 && idx < (int)gridDim.x) { if (__hip_atomic_load(flags + idx, __ATOMIC_RELAXED, __HIP_MEMORY_SCOPE_AGENT) < gen) ok = false; } }
        if (__builtin_amdgcn_ballot_w64(!ok) == 0ull) break;
        __builtin_amdgcn_s_sleep(1);
      }
      if (tid == 0) __hip_atomic_store(rel, gen, __ATOMIC_RELAXED, __HIP_MEMORY_SCOPE_AGENT);
    } else if (tid == 0) {
      __hip_atomic_store(flags + blockIdx.x, gen, __ATOMIC_RELAXED, __HIP_MEMORY_SCOPE_AGENT);
      while (__hip_atomic_load(rel, __ATOMIC_RELAXED, __HIP_MEMORY_SCOPE_AGENT) < gen) __builtin_amdgcn_s_sleep(1);
    }
    __builtin_amdgcn_fence(__ATOMIC_ACQUIRE, "agent");
  }
  __syncthreads();
}

__global__ void __launch_bounds__(256, 2) mega(Params P, int ph0, int ph1, int coop) {
  extern __shared__ __attribute__((aligned(16))) char smem[];
  unsigned gen = 0;
  const int npre = 0;
  const int nit = npre + (ph1 - ph0);
  for (int it = 0; it < nit; ++it) {
    const int ph = it < npre ? it : ph0 + (it - npre);
    run_phase(P, ph, smem);
    if (coop && it + 1 < nit) {
      if (it == 0) cg::this_grid().sync();
      else grid_barrier(P.ws, ++gen);
    }
  }
}

extern "C" void kernel_launch(void* const* d_in, const int* in_sizes, int n_in, void* d_out, int out_size, void* d_ws, size_t ws_size, hipStream_t stream) {
  static int grid = 0;
  if (grid == 0) {
    if (n_in != 21 || ws_size < WS_NEED) { fprintf(stderr, "kernel_launch: need 21 inputs and %zu bytes of workspace; got %d, %zu\n", (size_t)WS_NEED, n_in, ws_size); grid = -1; return; }
    int dev = 0, cus = 0, per_cu = 0;
    hipGetDevice(&dev);
    hipDeviceGetAttribute(&cus, hipDeviceAttributeMultiprocessorCount, dev);
    if (hipFuncSetAttribute((const void*)mega, hipFuncAttributeMaxDynamicSharedMemorySize, LDS_BYTES) != hipSuccess) { fprintf(stderr, "kernel_launch: hipFuncSetAttribute failed\n"); grid = -1; return; }
    if (hipOccupancyMaxActiveBlocksPerMultiprocessor(&per_cu, (const void*)mega, 256, LDS_BYTES) != hipSuccess || per_cu < 1) { fprintf(stderr, "kernel_launch: occupancy query failed (%d)\n", per_cu); per_cu = 1; }
    if (per_cu > 2) per_cu = 2;
    grid = cus * per_cu;
    fprintf(stderr, "kernel_launch: grid %d (%d CUs x %d)\n", grid, cus, per_cu);
  }
  if (grid < 0) return;
  hipMemsetAsync((char*)d_ws + OFF_CNT, 0, 4096, stream);
  Params p{};
  const float** pp = (const float**)&p;
  for (int i = 0; i < 21; ++i) pp[i] = (const float*)d_in[i];
  p.out = (float*)d_out; p.ws = (char*)d_ws;
#if MULTI_LAUNCH
  for (int ph = 0; ph < NPHASE; ++ph) hipLaunchKernelGGL(mega, dim3(grid), dim3(256), LDS_BYTES, stream, p, ph, ph + 1, 0);
#else
  int ph0 = 0, ph1 = NPHASE, coop = 1;
  void* args[] = {&p, &ph0, &ph1, &coop};
  hipError_t e = hipLaunchCooperativeKernel((const void*)mega, dim3(grid), dim3(256), args, LDS_BYTES, stream);
  if (e != hipSuccess) fprintf(stderr, "cooperative launch failed: %s (grid %d)\n", hipGetErrorString(e), grid);
#endif
}
```

```cpp
#include <hip/hip_runtime.h>
#include <hip/hip_cooperative_groups.h>
#include <cstdio>
#include <cstdint>
namespace cg = cooperative_groups;

#ifndef MULTI_LAUNCH
#define MULTI_LAUNCH 0
#endif

typedef unsigned short bf16_t;
typedef short s16x8 __attribute__((ext_vector_type(8)));
typedef short s16x4 __attribute__((ext_vector_type(4)));
typedef float f32x4 __attribute__((ext_vector_type(4)));
typedef float f32x2 __attribute__((ext_vector_type(2)));
typedef unsigned u32x4 __attribute__((ext_vector_type(4)));
typedef unsigned u32x2 __attribute__((ext_vector_type(2)));

constexpr int D = 1024, TR = 16896, PB = 8448, NCTX = 256, SEQ = 8192, INC = 10768, DFF = 4096;
constexpr int NMT = TR / 128;
constexpr float EPS = 1e-6f;
constexpr float QSCALE = 0.08838834764831845f * 1.4426950408889634f;
constexpr float MQSCALE = 0.08838834764831845f;

constexpr size_t E1 = (size_t)TR * 1024 * 2;
constexpr size_t OFF_CNT = 0;
constexpr size_t OFF_ROPE = 4096;
constexpr size_t OFF_MOD = OFF_ROPE + 128 * 32 * 8;
constexpr size_t OFF_GATES = OFF_MOD + 2 * 3 * 6144 * 4;
constexpr size_t OFF_CTXB = OFF_GATES + (size_t)TR * 16 * 4;
constexpr size_t OFF_W = OFF_CTXB + (size_t)512 * 1024 * 4;
constexpr size_t W_IN = 0, W_PM = W_IN + (size_t)10752 * 1024 * 2, W_PA = W_PM + 2097152, W_PC = W_PA + 2097152, W_O = W_PC + 2097152,
                 W_UP = W_O + 2097152, W_DN = W_UP + 8388608, W_END = W_DN + 8388608;
constexpr size_t OFF_S = OFF_W + W_END;
constexpr size_t OFF_PO = OFF_S + 8 * E1;
constexpr size_t OFF_ML = OFF_PO + (size_t)2 * 256 * 128 * 128 * 2;
constexpr size_t OFF_GW = OFF_ML + (size_t)2 * 256 * 128 * 8;
constexpr size_t WS_NEED = OFF_GW + (size_t)2 * 16 * 1024 * 4;

struct Params {
  const float *x, *c, *ctx, *c_ctx, *w_ada, *b_ada, *norm1, *norm2, *w_in, *gate_b, *mnorm, *qn, *kn, *conv_w, *wpm, *wpa, *wpc, *wout, *wup, *wdn, *fnorm;
  float* out; char* ws;
};

__device__ __forceinline__ int otid() { int t = threadIdx.x; asm volatile("" : "+v"(t)); return t; }
__device__ __forceinline__ float shx(float x, int m, int lane) { return __builtin_bit_cast(float, __builtin_amdgcn_ds_bpermute((lane ^ m) << 2, __builtin_bit_cast(int, x))); }
__device__ __forceinline__ float shl_(float x, int src) { return __builtin_bit_cast(float, __builtin_amdgcn_ds_bpermute(src << 2, __builtin_bit_cast(int, x))); }
__device__ __forceinline__ bf16_t* slot(const Params& P, int s) { return (bf16_t*)(P.ws + OFF_S + (size_t)s * E1); }
__device__ __forceinline__ bf16_t* wbuf(const Params& P, size_t off) { return (bf16_t*)(P.ws + OFF_W + off); }

__device__ __forceinline__ unsigned pk2(float lo, float hi) { unsigned r; asm("v_cvt_pk_bf16_f32 %0, %1, %2" : "=v"(r) : "v"(lo), "v"(hi)); return r; }
__device__ __forceinline__ bf16_t f2bf(float f) { return (bf16_t)(pk2(f, f) & 0xffffu); }
__device__ __forceinline__ float bflo(unsigned u) { return __uint_as_float(u << 16); }
__device__ __forceinline__ float bfhi(unsigned u) { return __uint_as_float(u & 0xffff0000u); }
__device__ __forceinline__ float sigmoidf_(float x) { return 1.f / (1.f + __expf(-x)); }

__device__ __forceinline__ const float* xsrc_row(const Params& P, bool useInput, int R) {
  const int b = R / PB, p = R - b * PB;
  if (p < NCTX) return (useInput ? P.ctx : (const float*)(P.ws + OFF_CTXB)) + (size_t)(b * NCTX + p) * D;
  return (useInput ? P.x : (const float*)P.out) + (size_t)(b * SEQ + p - NCTX) * D;
}
__device__ __forceinline__ float* xdst_row(const Params& P, int R) {
  const int b = R / PB, p = R - b * PB;
  if (p < NCTX) return (float*)(P.ws + OFF_CTXB) + (size_t)(b * NCTX + p) * D;
  return P.out + (size_t)(b * SEQ + p - NCTX) * D;
}
__device__ __forceinline__ const float* modrow(const Params& P, int layer, int R0) {
  const int b = R0 / PB, p = R0 - b * PB;
  const int mi = (p < NCTX) ? 2 : b;
  return (const float*)(P.ws + OFF_MOD) + (size_t)(layer * 3 + mi) * 6144;
}

constexpr int LDT = 72;
constexpr int LDG = 40;
typedef float f32x16 __attribute__((ext_vector_type(16)));
template <int MW, int NT>
__device__ __forceinline__ void gemm_core(const bf16_t* __restrict__ A, int lda, const bf16_t* __restrict__ Bt, int ldb, int K, f32x16 (&acc)[MW / 2][NT / 2], bf16_t* sm) {
  const int tid = otid(), lane = tid & 63, w = tid >> 6, r = lane & 31, h = lane >> 5;
  const int ldr = tid >> 3, ldk = (tid & 7) * 8;
  constexpr int NA = 2 * MW, NB = NT / 2, LDK = 72;
  u32x4 ra[NA], rb[NB];
  const bf16_t* ap = A + (size_t)ldr * lda + ldk;
  const bf16_t* bp = Bt + (size_t)ldr * ldb + ldk;
  bf16_t* As = sm; bf16_t* Bs = sm + 64 * MW * LDK;
  const int nk = K >> 6;
  auto gload = [&](int kt) {
#pragma unroll
    for (int i = 0; i < NA; ++i) ra[i] = *(const u32x4*)(ap + (size_t)(32 * i) * lda + kt * 64);
#pragma unroll
    for (int i = 0; i < NB; ++i) rb[i] = *(const u32x4*)(bp + (size_t)(32 * i) * ldb + kt * 64);
  };
  gload(0);
  for (int kt = 0; kt < nk; ++kt) {
    __syncthreads();
#pragma unroll
    for (int i = 0; i < NA; ++i) *(u32x4*)(As + (ldr + 32 * i) * LDK + ldk) = ra[i];
#pragma unroll
    for (int i = 0; i < NB; ++i) *(u32x4*)(Bs + (ldr + 32 * i) * LDK + ldk) = rb[i];
    __syncthreads();
    gload(min(kt + 1, nk - 1));
    __builtin_amdgcn_s_setprio(1);
#pragma unroll
    for (int ks = 0; ks < 4; ++ks) {
      s16x8 af[MW / 2], bfr[NT / 2];
#pragma unroll
      for (int m = 0; m < MW / 2; ++m) af[m] = *(const s16x8*)(As + (16 * MW * w + 32 * m + r) * LDK + 16 * ks + 8 * h);
#pragma unroll
      for (int n = 0; n < NT / 2; ++n) bfr[n] = *(const s16x8*)(Bs + (32 * n + r) * LDK + 16 * ks + 8 * h);
#pragma unroll
      for (int m = 0; m < MW / 2; ++m)
#pragma unroll
        for (int n = 0; n < NT / 2; ++n) acc[m][n] = __builtin_amdgcn_mfma_f32_32x32x16_bf16(af[m], bfr[n], acc[m][n], 0, 0, 0);
    }
    __builtin_amdgcn_s_setprio(0);
  }
  __syncthreads();
}

template <int MW, int NT>
__device__ __forceinline__ void zero_acc(f32x16 (&acc)[MW / 2][NT / 2]) {
#pragma unroll
  for (int m = 0; m < MW / 2; ++m)
#pragma unroll
    for (int n = 0; n < NT / 2; ++n)
#pragma unroll
      for (int e = 0; e < 16; ++e) acc[m][n][e] = 0.f;
}
__device__ __forceinline__ int big_R0(int bt) { return (bt >> 5) * PB + NCTX + (bt & 31) * 256; }
__device__ __forceinline__ int small_R0(int st) { return (st >> 1) * PB + (st & 1) * 128; }

__device__ __forceinline__ int winmap(int n) {
  if (n < 3072) return n;
  if (n < 4608) return n + 16;
  if (n < 5632) return 5648 + (n - 4608);
  if (n < 7680) { const int j = (n - 5632) >> 7, c = (n - 5632) & 127; return c < 64 ? 4624 + 64 * j + c : 6672 + 64 * j + (c - 64); }
  return 7696 + (n - 7680);
}
__device__ void convert_tile(const float* __restrict__ src, int lds, int srccol0, bf16_t* __restrict__ dst, int K, int kt, int n0, float* tl) {
  const int tid = otid();
  __syncthreads();
#pragma unroll
  for (int i = 0; i < 4; ++i) {
    const int k = i * 16 + (tid >> 4), n4 = (tid & 15) * 4;
    const f32x4 v = *(const f32x4*)(src + (size_t)(kt * 64 + k) * lds + srccol0 + n4);
    tl[k * 65 + n4] = v[0]; tl[k * 65 + n4 + 1] = v[1]; tl[k * 65 + n4 + 2] = v[2]; tl[k * 65 + n4 + 3] = v[3];
  }
  __syncthreads();
  const int n = tid >> 2, ks = (tid & 3) * 16;
  u32x4 o0, o1;
  o0.x = pk2(tl[(ks + 0) * 65 + n], tl[(ks + 1) * 65 + n]); o0.y = pk2(tl[(ks + 2) * 65 + n], tl[(ks + 3) * 65 + n]);
  o0.z = pk2(tl[(ks + 4) * 65 + n], tl[(ks + 5) * 65 + n]); o0.w = pk2(tl[(ks + 6) * 65 + n], tl[(ks + 7) * 65 + n]);
  o1.x = pk2(tl[(ks + 8) * 65 + n], tl[(ks + 9) * 65 + n]); o1.y = pk2(tl[(ks + 10) * 65 + n], tl[(ks + 11) * 65 + n]);
  o1.z = pk2(tl[(ks + 12) * 65 + n], tl[(ks + 13) * 65 + n]); o1.w = pk2(tl[(ks + 14) * 65 + n], tl[(ks + 15) * 65 + n]);
  bf16_t* d = dst + (size_t)(n0 + n) * K + kt * 64 + ks;
  *(u32x4*)d = o0; *(u32x4*)(d + 8) = o1;
}
constexpr int CONV_A_ITEMS = 2688 + 4 * 256, CONV_B_ITEMS = 2048;
__device__ void convert_item(const Params& P, int layer, int set, int item, float* tl) {
  if (set == 0) {
    if (item < 2688) { const int nt = item % 168, kt = item / 168; convert_tile(P.w_in + (size_t)layer * 1024 * INC, INC, winmap(nt * 64), wbuf(P, W_IN), 1024, kt, nt * 64, tl); return; }
    item -= 2688; const int j = item >> 8, t = item & 255, nt = t & 15, kt = t >> 4;
    const float* src = (j == 0 ? P.wpm : j == 1 ? P.wpa : j == 2 ? P.wpc : P.wout) + (size_t)layer * 1024 * 1024;
    convert_tile(src, 1024, nt * 64, wbuf(P, W_PM + (size_t)j * 2097152), 1024, kt, nt * 64, tl);
  } else {
    if (item < 1024) { const int nt = item & 63, kt = item >> 6; convert_tile(P.wup + (size_t)layer * 1024 * 4096, 4096, nt * 64, wbuf(P, W_UP), 1024, kt, nt * 64, tl); }
    else { item -= 1024; const int nt = item & 15, kt = item >> 4; convert_tile(P.wdn + (size_t)layer * 4096 * 1024, 1024, nt * 64, wbuf(P, W_DN), 4096, kt, nt * 64, tl); }
  }
}

__device__ void mod_item(const Params& P, int item, float* sv) {
  const int tid = otid(), l = item / 96, j0 = (item % 96) * 64;
  __syncthreads();
  for (int idx = tid; idx < 3072; idx += 256) { const int mi = idx >> 10, k = idx & 1023; const float v = mi < 2 ? P.c[mi * 1024 + k] : P.c_ctx[k]; sv[idx] = v / (1.f + __expf(-v)); }
  __syncthreads();
  const int kg = tid >> 6, jl = tid & 63;
  float a0 = 0.f, a1 = 0.f, a2 = 0.f;
  const float* wp = P.w_ada + ((size_t)l * 1024 + kg * 256) * 6144 + j0 + jl;
#pragma unroll 8
  for (int k = 0; k < 256; ++k) { const float wv = wp[(size_t)k * 6144]; a0 += sv[kg * 256 + k] * wv; a1 += sv[1024 + kg * 256 + k] * wv; a2 += sv[2048 + kg * 256 + k] * wv; }
  float* red = sv + 3072;
  red[(kg * 3 + 0) * 64 + jl] = a0; red[(kg * 3 + 1) * 64 + jl] = a1; red[(kg * 3 + 2) * 64 + jl] = a2;
  __syncthreads();
  if (tid < 192) { const int m = tid >> 6; float s = P.b_ada[l * 6144 + j0 + jl];
    for (int q = 0; q < 4; ++q) s += red[(q * 3 + m) * 64 + jl];
    ((float*)(P.ws + OFF_MOD))[(size_t)(l * 3 + m) * 6144 + j0 + jl] = s; }
}
__device__ void rope_item(const Params& P) {
  const int tid = otid();
  f32x2* rt = (f32x2*)(P.ws + OFF_ROPE);
  for (int e = tid; e < 4096; e += 256) {
    const int pos = e >> 5, f = e & 31;
    double inv = 1.0; for (int q = 0; q < f; ++q) inv *= 0.7498942093324559;
    const float invf = (float)inv; const float angf = (float)pos * invf;
    const double x = (double)angf;
    const double n = rint(x / 6.283185307179586), r = x - n * 6.283185307179586, r2 = r * r;
    double ts = 1.0, tc = 1.0, ss = 1.0, sc = 1.0;
    for (int k = 1; k <= 14; ++k) { tc *= -r2 / (double)((2 * k - 1) * (2 * k)); sc += tc; ts *= -r2 / (double)((2 * k) * (2 * k + 1)); ss += ts; }
    rt[e] = (f32x2){(float)sc, (float)(r * ss)};
  }
}
__device__ void phase_prologue(const Params& P, char* sm) {
  for (int i = blockIdx.x * 256 + otid(); i < 512 * 1024 / 4; i += gridDim.x * 256) ((f32x4*)(P.ws + OFF_CTXB))[i] = ((const f32x4*)P.ctx)[i];
  const int NI = CONV_A_ITEMS + CONV_B_ITEMS + 192 + 1 + 2;
  for (int it = blockIdx.x; it < NI; it += gridDim.x) {
    if (it < CONV_A_ITEMS) convert_item(P, 0, 0, it, (float*)sm);
    else if (it < CONV_A_ITEMS + CONV_B_ITEMS) convert_item(P, 0, 1, it - CONV_A_ITEMS, (float*)sm);
    else if (it < CONV_A_ITEMS + CONV_B_ITEMS + 192) mod_item(P, it - CONV_A_ITEMS - CONV_B_ITEMS, (float*)sm);
    else if (it == CONV_A_ITEMS + CONV_B_ITEMS + 192) rope_item(P);
    else {
      const int l = it - (CONV_A_ITEMS + CONV_B_ITEMS + 193);
      const float* wi = P.w_in + (size_t)l * 1024 * INC + 3072; float* gw = (float*)(P.ws + OFF_GW) + l * 16384;
      for (int idx = otid(); idx < 16384; idx += 256) { const int k = idx >> 4, j = idx & 15; gw[j * 1024 + k] = wi[(size_t)k * INC + j]; }
    }
  }
}

__device__ void phase_norm(const Params& P, int layer, int which, char* smc) {
  float* wgt = (float*)smc;
  const int tid = otid(), lane = tid & 63, w = tid >> 6;
  if (which == 0) {
    const f32x4* gw = (const f32x4*)(P.ws + OFF_GW) + layer * 4096;
#pragma unroll
    for (int i = 0; i < 16; ++i) ((f32x4*)wgt)[tid + 256 * i] = gw[tid + 256 * i];
    __syncthreads();
  }
  const float* gvec = (which == 0 ? P.norm1 : P.norm2) + layer * 1024;
  bf16_t* hout = slot(P, 0);
  auto loadrow = [&](int R, f32x4 (&xv)[4]) {
    const float* xr = (which == 0) ? xsrc_row(P, layer == 0, R) : (const float*)xdst_row(P, R);
#pragma unroll
    for (int i = 0; i < 4; ++i) xv[i] = *(const f32x4*)(xr + 256 * i + lane * 4);
  };
  const int rstride = gridDim.x * 4;
  f32x4 xn[4];
  int R = blockIdx.x * 4 + w;
  if (R < TR) loadrow(R, xn);
  for (; R < TR; R += rstride) {
    f32x4 xv[4];
#pragma unroll
    for (int i = 0; i < 4; ++i) xv[i] = xn[i];
    if (R + rstride < TR) loadrow(R + rstride, xn);
    const int b = R / PB, p = R - b * PB;
    if (layer == 1 && which == 1 && p < NCTX) continue;
    const float* mod = (const float*)(P.ws + OFF_MOD) + (size_t)(layer * 3 + (p < NCTX ? 2 : b)) * 6144 + (which == 0 ? 0 : 3072);
    f32x4 gv4[4], sh4[4], sc4[4];
#pragma unroll
    for (int i = 0; i < 4; ++i) { const int col = 256 * i + lane * 4; gv4[i] = *(const f32x4*)(gvec + col); sh4[i] = *(const f32x4*)(mod + col); sc4[i] = *(const f32x4*)(mod + 1024 + col); }
    float ss = 0.f;
#pragma unroll
    for (int i = 0; i < 4; ++i) ss += xv[i][0] * xv[i][0] + xv[i][1] * xv[i][1] + xv[i][2] * xv[i][2] + xv[i][3] * xv[i][3];
#pragma unroll
    for (int o = 32; o >= 1; o >>= 1) ss += shx(ss, o, lane);
    const float rstd = rsqrtf(ss * (1.f / 1024.f) + EPS);
#pragma unroll
    for (int i = 0; i < 4; ++i) {
#pragma unroll
      for (int e = 0; e < 4; ++e) xv[i][e] = (xv[i][e] * rstd * gv4[i][e]) * (1.f + sc4[i][e]) + sh4[i][e];
    }
#pragma unroll
    for (int i = 0; i < 4; ++i) {
      u32x2 o; o.x = pk2(xv[i][0], xv[i][1]); o.y = pk2(xv[i][2], xv[i][3]);
      *(u32x2*)(hout + (size_t)R * 1024 + 256 * i + lane * 4) = o;
    }
    if (which == 0) {
      float sj[16];
#pragma unroll
      for (int j = 0; j < 16; ++j) {
        float sacc = 0.f;
#pragma unroll
        for (int i = 0; i < 4; ++i) { const f32x4 wv = *(const f32x4*)(wgt + j * 1024 + 256 * i + lane * 4); sacc += xv[i][0] * wv[0] + xv[i][1] * wv[1] + xv[i][2] * wv[2] + xv[i][3] * wv[3]; }
        sj[j] = sacc;
      }
      const bool b5 = lane & 32, b4 = lane & 16, b3 = lane & 8, b2 = lane & 4;
      float a8[8], a4[4], a2[2];
#pragma unroll
      for (int j = 0; j < 8; ++j) { const float keep = b5 ? sj[8 + j] : sj[j], send = b5 ? sj[j] : sj[8 + j]; a8[j] = keep + shx(send, 32, lane); }
#pragma unroll
      for (int j = 0; j < 4; ++j) { const float keep = b4 ? a8[4 + j] : a8[j], send = b4 ? a8[j] : a8[4 + j]; a4[j] = keep + shx(send, 16, lane); }
#pragma unroll
      for (int j = 0; j < 2; ++j) { const float keep = b3 ? a4[2 + j] : a4[j], send = b3 ? a4[j] : a4[2 + j]; a2[j] = keep + shx(send, 8, lane); }
      float e = (b2 ? a2[1] : a2[0]) + shx(b2 ? a2[0] : a2[1], 4, lane);
      e += shx(e, 1, lane); e += shx(e, 2, lane);
      if ((lane & 3) == 0) ((float*)(P.ws + OFF_GATES))[(size_t)R * 16 + (lane >> 2)] = e + P.gate_b[layer * 16 + (lane >> 2)];
    }
  }
  if (which == 1 && layer == 0) { for (int it = blockIdx.x; it < CONV_A_ITEMS; it += gridDim.x) convert_item(P, 1, 0, it, (float*)smc); }
  if (which == 0 && layer == 1) { for (int it = blockIdx.x; it < CONV_B_ITEMS; it += gridDim.x) convert_item(P, 1, 1, it, (float*)smc); }
}

__device__ __forceinline__ bool gemm_unit(int i, int NTN, bool withCtx, bool& isBig, int& R0, int& nt) {
  const int x = blockIdx.x & 7, loc = blockIdx.x >> 3, nloc = gridDim.x >> 3;
  int j = loc + i * nloc;
  if (j < 8 * NTN) {
    const int jl = j & 63;
    isBig = true; nt = (j >> 6) * 8 + ((jl & 1) | ((jl >> 4) << 1)); R0 = big_R0(8 * x + ((jl >> 1) & 7)); return true;
  }
  j -= 8 * NTN;
  if (!withCtx) return false;
  const int sidx = x + 8 * j;
  if (sidx >= 4 * NTN) return false;
  isBig = false; nt = sidx % NTN; R0 = small_R0(sidx / NTN); return true;
}

template <int NT>
__device__ __forceinline__ void flush_pass(const bf16_t* smw, bf16_t* dst, int ld, int lane) {
  constexpr int LDW = 16 * NT + 8, CPR = 2 * NT;
#pragma unroll
  for (int j = 0; j < NT; ++j) {
    const int c = lane + 64 * j, row = c / CPR, cc = c % CPR;
    const u32x4 v = *(const u32x4*)(smw + row * LDW + cc * 8);
    *(u32x4*)(dst + (size_t)row * ld + cc * 8) = v;
  }
}
template <int MW, int LD>
__device__ __forceinline__ void store_nat(const f32x16 (&acc)[MW / 2][4], bf16_t* base, float scale, bf16_t* sm, int w, int lane) {
  const int r = lane & 31, h = lane >> 5;
  bf16_t* smw = sm + w * 32 * 136;
#pragma unroll
  for (int m = 0; m < MW / 2; ++m) {
#pragma unroll
    for (int q = 0; q < 4; ++q)
#pragma unroll
      for (int i = 0; i < 4; ++i)
#pragma unroll
        for (int n = 0; n < 4; ++n) smw[(8 * q + 4 * h + i) * 136 + 32 * n + r] = f2bf(acc[m][n][4 * q + i] * scale);
    flush_pass<8>(smw, base + (size_t)(16 * MW * w + 32 * m) * LD, LD, lane);
  }
}
template <int MW>
__device__ __forceinline__ void store_tr(const f32x16 (&acc)[MW / 2][4], bf16_t* base, bf16_t* sm, int w, int lane) {
  const int r = lane & 31, h = lane >> 5;
  constexpr int TOK = 16 * MW, LDW = TOK + 8, CPR = TOK / 8;
  bf16_t* smw = sm + 4 * 32 * 136 + w * 64 * 72;
#pragma unroll
  for (int ps = 0; ps < 2; ++ps) {
#pragma unroll
    for (int nn = 0; nn < 2; ++nn)
#pragma unroll
      for (int m = 0; m < MW / 2; ++m)
#pragma unroll
        for (int q = 0; q < 4; ++q) {
          u32x2 o; o.x = pk2(acc[m][2 * ps + nn][4 * q], acc[m][2 * ps + nn][4 * q + 1]); o.y = pk2(acc[m][2 * ps + nn][4 * q + 2], acc[m][2 * ps + nn][4 * q + 3]);
          *(u32x2*)(smw + (32 * nn + r) * LDW + 32 * m + 8 * q + 4 * h) = o;
        }
#pragma unroll
    for (int j = 0; j < CPR; ++j) {
      const int c = lane + 64 * j, row = c / CPR, cc = c % CPR;
      const u32x4 v = *(const u32x4*)(smw + row * LDW + cc * 8);
      *(u32x4*)(base + (size_t)(64 * ps + row) * PB + 16 * MW * w + cc * 8) = v;
    }
  }
}
template <int MW>
__device__ __forceinline__ void inproj_tile(const Params& P, int layer, int R0, int nt_, bf16_t* sm) {
  const int tid = otid(), lane = tid & 63, w = tid >> 6, r = lane & 31, h = lane >> 5;
  const bf16_t* h1 = slot(P, 0);
  const bf16_t* WinT = wbuf(P, W_IN);
  bf16_t* cu = slot(P, 1); bf16_t* cB = slot(P, 2);
  bf16_t* mq = slot(P, 3); bf16_t* mk = mq + (size_t)TR * 512;
  bf16_t* mkT = slot(P, 4); bf16_t* ak = mkT + (size_t)TR * 512; bf16_t* avT = ak + (size_t)TR * 256;
  bf16_t* mvT = slot(P, 5); bf16_t* mo = slot(P, 6); bf16_t* aq = slot(P, 7);
  const f32x2* rope = (const f32x2*)(P.ws + OFF_ROPE);
  f32x16 acc[MW / 2][4]; zero_acc<MW, 8>(acc);
  gemm_core<MW, 8>(h1 + (size_t)R0 * 1024, 1024, WinT + (size_t)nt_ * 128 * 1024, 1024, 1024, acc, sm);
  const int b = R0 / PB, p0 = R0 - b * PB, rw = 16 * MW * w;
  if (nt_ < 4) store_nat<MW, 512>(acc, mq + (size_t)R0 * 512 + nt_ * 128, MQSCALE, sm, w, lane);
  else if (nt_ < 8) { store_nat<MW, 512>(acc, mk + (size_t)R0 * 512 + (nt_ - 4) * 128, 1.f, sm, w, lane); store_tr<MW>(acc, mkT + (size_t)(b * 512 + (nt_ - 4) * 128) * PB + p0, sm, w, lane); }
  else if (nt_ < 16) store_tr<MW>(acc, mvT + (size_t)(b * 1024 + (nt_ - 8) * 128) * PB + p0, sm, w, lane);
  else if (nt_ < 24) store_nat<MW, 1024>(acc, mo + (size_t)R0 * 1024 + (nt_ - 16) * 128, 1.f, sm, w, lane);
  else if (nt_ < 34) {
    const bool isq = nt_ < 32;
    const float* gn = (isq ? P.qn : P.kn) + layer * 128;
    float gv[4];
#pragma unroll
    for (int n = 0; n < 4; ++n) gv[n] = gn[32 * n + r];
    const float scale = isq ? QSCALE : 1.f;
    bf16_t* smw = sm + w * 32 * 136;
#pragma unroll
    for (int m = 0; m < MW / 2; ++m) {
#pragma unroll
      for (int q = 0; q < 4; ++q)
#pragma unroll
        for (int i = 0; i < 4; ++i) {
          float v[4]; float ss = 0.f;
#pragma unroll
          for (int n = 0; n < 4; ++n) { v[n] = acc[m][n][4 * q + i]; ss += v[n] * v[n]; }
          ss += shx(ss, 1, lane); ss += shx(ss, 2, lane); ss += shx(ss, 4, lane); ss += shx(ss, 8, lane); ss += shx(ss, 16, lane);
          const float rstd = rsqrtf(ss * (1.f / 128.f) + EPS);
#pragma unroll
          for (int n = 0; n < 4; ++n) v[n] = v[n] * rstd * gv[n];
          if (p0 >= NCTX) {
            const int sidx = p0 - NCTX + rw + 32 * m + 8 * q + 4 * h + i, ri = sidx >> 6, ci = sidx & 63;
            const f32x2 a = rope[ri * 32 + r]; const float x1 = v[0], x2 = v[1];
            v[0] = x1 * a.x - x2 * a.y; v[1] = x1 * a.y + x2 * a.x;
            const f32x2 c2 = rope[ci * 32 + r]; const float y1 = v[2], y2 = v[3];
            v[2] = y1 * c2.x - y2 * c2.y; v[3] = y1 * c2.y + y2 * c2.x;
          }
#pragma unroll
          for (int n = 0; n < 4; ++n) smw[(8 * q + 4 * h + i) * 136 + 32 * n + r] = f2bf(v[n] * scale);
        }
      if (isq) flush_pass<8>(smw, aq + (size_t)(R0 + rw + 32 * m) * 1024 + (nt_ - 24) * 128, 1024, lane);
      else flush_pass<8>(smw, ak + (size_t)(R0 + rw + 32 * m) * 256 + (nt_ - 32) * 128, 256, lane);
    }
  }
  else if (nt_ < 36) store_tr<MW>(acc, avT + (size_t)(b * 256 + (nt_ - 34) * 128) * PB + p0, sm, w, lane);
  else if (nt_ < 44) store_nat<MW, 1024>(acc, cB + (size_t)R0 * 1024 + (nt_ - 36) * 128, 1.f, sm, w, lane);
  else {
    bf16_t* smw = sm + w * 32 * 72;
#pragma unroll
    for (int m = 0; m < MW / 2; ++m) {
#pragma unroll
      for (int q = 0; q < 4; ++q)
#pragma unroll
        for (int i = 0; i < 4; ++i)
#pragma unroll
          for (int n = 0; n < 2; ++n) smw[(8 * q + 4 * h + i) * 72 + 32 * n + r] = f2bf(acc[m][n][4 * q + i] * acc[m][n + 2][4 * q + i]);
      flush_pass<4>(smw, cu + (size_t)(R0 + rw + 32 * m) * 1024 + 64 * (nt_ - 44), 1024, lane);
    }
  }
}
__device__ void phase_inproj(const Params& P, int layer, char* smc) {
  bf16_t* sm = (bf16_t*)smc;
  for (int i = 0;; ++i) {
    bool big; int R0, nt;
    if (!gemm_unit(i, 60, true, big, R0, nt)) break;
    if (big) inproj_tile<4>(P, layer, R0, nt, sm); else inproj_tile<2>(P, layer, R0, nt, sm);
  }
}

__device__ void phase_conv(const Params& P, int layer) {
  const bf16_t* cu = slot(P, 1); bf16_t* cB = slot(P, 2);
  const float* cw = P.conv_w + (size_t)layer * 3 * 1024;
  const int tid = otid();
  const int stride = gridDim.x * 256;
  int idx = blockIdx.x * 256 + tid;
  const int ch = (idx & 127) * 8;
  float w0[8], w1[8], w2[8];
#pragma unroll
  for (int e = 0; e < 8; ++e) { w0[e] = cw[ch + e]; w1[e] = cw[1024 + ch + e]; w2[e] = cw[2048 + ch + e]; }
  const u32x4 z = {0u, 0u, 0u, 0u};
  auto loaditem = [&](int id, u32x4& c0, u32x4& c1, u32x4& c2, u32x4& bg) {
    const int R = id >> 7, p = R % PB;
    const bool hasL = !(p == 0 || p == NCTX), hasR = !(p == NCTX - 1 || p == PB - 1);
    c1 = *(const u32x4*)(cu + (size_t)R * 1024 + ch);
    c0 = hasL ? *(const u32x4*)(cu + (size_t)(R - 1) * 1024 + ch) : z;
    c2 = hasR ? *(const u32x4*)(cu + (size_t)(R + 1) * 1024 + ch) : z;
    bg = *(const u32x4*)(cB + (size_t)R * 1024 + ch);
  };
  u32x4 n0 = z, n1 = z, n2 = z, nb = z;
  if (idx < TR * 128) loaditem(idx, n0, n1, n2, nb);
  for (; idx < TR * 128; idx += stride) {
    const u32x4 c0 = n0, c1 = n1, c2 = n2, bg = nb;
    if (idx + stride < TR * 128) loaditem(idx + stride, n0, n1, n2, nb);
    u32x4 o;
#pragma unroll
    for (int q = 0; q < 4; ++q) {
      const float lo = bflo(bg[q]) * (w0[2 * q] * bflo(c0[q]) + w1[2 * q] * bflo(c1[q]) + w2[2 * q] * bflo(c2[q]));
      const float hi = bfhi(bg[q]) * (w0[2 * q + 1] * bfhi(c0[q]) + w1[2 * q + 1] * bfhi(c1[q]) + w2[2 * q + 1] * bfhi(c2[q]));
      o[q] = pk2(lo, hi);
    }
    *(u32x4*)(cB + (size_t)(idx >> 7) * 1024 + ch) = o;
  }
}

constexpr int ML_QS = 0, ML_KS = 8704, ML_KW = 17408, ML_VT = 26624, ML_CT = 30080, ML_VEC_B = 73216;
__device__ void mlstm_run(const Params& P, int wg, char* smc) {
  bf16_t* sm = (bf16_t*)smc;
  bf16_t* Qs = sm + ML_QS; bf16_t* Ks = sm + ML_KS; bf16_t* KWt = sm + ML_KW; bf16_t* Vt = sm + ML_VT; bf16_t* Ct = sm + ML_CT; bf16_t* Ps = Ks;
  float* Arow = (float*)(smc + ML_VEC_B); float* Bcol = Arow + 64; float* avec = Bcol + 64; float* wkv = avec + 64; float* eFs = wkv + 64;
  const int tid = otid(), lane = tid & 63, w = tid >> 6, lr = lane & 15, g = lane >> 4;
  const int slice = wg & 7, dir = (wg >> 3) & 1, h = (wg >> 4) & 3, b = wg >> 6, v0 = slice * 32;
  const bf16_t* mq = slot(P, 3); const bf16_t* mk = mq + (size_t)TR * 512; const bf16_t* mkT = slot(P, 4); const bf16_t* mvT = slot(P, 5);
  const float* G = (const float*)(P.ws + OFF_GATES);
  bf16_t* hdir = slot(P, dir == 0 ? 1 : 0);
  __syncthreads();
  for (int idx = tid; idx < 16 * LDT; idx += 256) Vt[32 * LDT + idx] = (idx < LDT) ? (bf16_t)0x3F80 : (bf16_t)0;
  f32x4 Cacc[2][3];
#pragma unroll
  for (int a = 0; a < 2; ++a)
#pragma unroll
    for (int n = 0; n < 3; ++n) Cacc[a][n] = (f32x4){0.f, 0.f, 0.f, 0.f};
  u32x4 rq[4], rk[4], rkt[4], rvt; float gi = 0.f, gf = 0.f;
  const int qs_r = tid >> 4, qs_c = (tid & 15) * 8;
  const int kt_d = tid >> 3, kt_s = (tid & 7) * 8;
  auto chunk_p0 = [&](int n) { const int c = (dir == 0) ? n : (n < 4 ? 3 - n : 135 - n); return c * 64; };
  auto prefetch = [&](int n) {
    const int p0 = chunk_p0(n); const size_t R0 = (size_t)b * PB + p0;
#pragma unroll
    for (int i = 0; i < 4; ++i) {
      rq[i] = *(const u32x4*)(mq + (R0 + qs_r + 16 * i) * 512 + h * 128 + qs_c);
      rk[i] = *(const u32x4*)(mk + (R0 + qs_r + 16 * i) * 512 + h * 128 + qs_c);
      rkt[i] = *(const u32x4*)(mkT + (size_t)(b * 512 + h * 128 + kt_d + 32 * i) * PB + p0 + kt_s);
    }
    rvt = *(const u32x4*)(mvT + (size_t)(b * 1024 + h * 256 + v0 + kt_d) * PB + p0 + kt_s);
    if (tid < 64) { gi = G[(R0 + tid) * 16 + dir * 8 + h]; gf = G[(R0 + tid) * 16 + dir * 8 + 4 + h]; }
  };
  prefetch(0);
  for (int n = 0; n < 132; ++n) {
    const int p0 = chunk_p0(n); const size_t R0 = (size_t)b * PB + p0;
    __syncthreads();
#pragma unroll
    for (int i = 0; i < 4; ++i) { *(u32x4*)(Qs + (qs_r + 16 * i) * 136 + qs_c) = rq[i]; *(u32x4*)(Ks + (qs_r + 16 * i) * 136 + qs_c) = rk[i]; }
    *(u32x4*)(Vt + kt_d * LDT + kt_s) = rvt;
#pragma unroll
    for (int a = 0; a < 2; ++a)
#pragma unroll
      for (int nv = 0; nv < 3; ++nv) { u32x2 o; o.x = pk2(Cacc[a][nv][0], Cacc[a][nv][1]); o.y = pk2(Cacc[a][nv][2], Cacc[a][nv][3]);
        *(u32x2*)(Ct + (16 * nv + lr) * 136 + 16 * (2 * w + a) + 4 * g) = o; }
    if (w == 0) {
      const float lf = fminf(gf, 0.f) - __logf(1.f + __expf(-fabsf(gf)));
      float bc = lf;
#pragma unroll
      for (int off = 1; off < 64; off <<= 1) {
        const float o = shl_(bc, ((dir == 0) ? lane - off : lane + off) & 63);
        const bool ok = (dir == 0) ? (lane >= off) : (lane + off < 64);
        if (ok) bc += o;
      }
      const float Ftot = shl_(bc, dir == 0 ? 63 : 0);
      Arow[lane] = bc; Bcol[lane] = gi - bc; avec[lane] = __expf(bc); wkv[lane] = __expf(Ftot - bc + gi);
      if (lane == 0) eFs[0] = __expf(Ftot);
    }
    __syncthreads();
    {
      const f32x4 wa = *(const f32x4*)(wkv + kt_s), wb = *(const f32x4*)(wkv + kt_s + 4);
#pragma unroll
      for (int i = 0; i < 4; ++i) {
        u32x4 o;
        o.x = pk2(bflo(rkt[i].x) * wa[0], bfhi(rkt[i].x) * wa[1]); o.y = pk2(bflo(rkt[i].y) * wa[2], bfhi(rkt[i].y) * wa[3]);
        o.z = pk2(bflo(rkt[i].z) * wb[0], bfhi(rkt[i].z) * wb[1]); o.w = pk2(bflo(rkt[i].w) * wb[2], bfhi(rkt[i].w) * wb[3]);
        *(u32x4*)(KWt + (kt_d + 32 * i) * LDT + kt_s) = o;
      }
    }
    s16x8 qf[4];
#pragma unroll
    for (int ks = 0; ks < 4; ++ks) qf[ks] = *(const s16x8*)(Qs + (16 * w + lr) * 136 + 32 * ks + 8 * g);
    f32x4 sT[4];
#pragma unroll
    for (int st = 0; st < 4; ++st) {
      sT[st] = (f32x4){0.f, 0.f, 0.f, 0.f};
#pragma unroll
      for (int ks = 0; ks < 4; ++ks) { const s16x8 kf = *(const s16x8*)(Ks + (16 * st + lr) * 136 + 32 * ks + 8 * g); sT[st] = __builtin_amdgcn_mfma_f32_16x16x32_bf16(kf, qf[ks], sT[st], 0, 0, 0); }
    }
    {
      const int t = 16 * w + lr; const float ar = Arow[t];
#pragma unroll
      for (int st = 0; st < 4; ++st) {
        const f32x4 bc4 = *(const f32x4*)(Bcol + 16 * st + 4 * g);
#pragma unroll
        for (int i = 0; i < 4; ++i) {
          const int s = 16 * st + 4 * g + i;
          const bool ok = (dir == 0) ? (s <= t) : (s >= t);
          sT[st][i] = ok ? sT[st][i] * __expf(ar + bc4[i]) : 0.f;
        }
      }
    }
    __syncthreads();
    if (n + 1 < 132) prefetch(n + 1);
    s16x8 vf[3][2];
#pragma unroll
    for (int nv = 0; nv < 3; ++nv)
#pragma unroll
      for (int sg = 0; sg < 2; ++sg) {
        const u32x2 lo = *(const u32x2*)(Vt + (16 * nv + lr) * LDT + 32 * sg + 4 * g), hi = *(const u32x2*)(Vt + (16 * nv + lr) * LDT + 32 * sg + 16 + 4 * g);
        u32x4 vv; vv.x = lo.x; vv.y = lo.y; vv.z = hi.x; vv.w = hi.y; vf[nv][sg] = __builtin_bit_cast(s16x8, vv);
      }
    f32x4 hI[3], hC[3];
#pragma unroll
    for (int nv = 0; nv < 3; ++nv) { hI[nv] = (f32x4){0.f, 0.f, 0.f, 0.f}; hC[nv] = (f32x4){0.f, 0.f, 0.f, 0.f}; }
#pragma unroll
    for (int sg = 0; sg < 2; ++sg) {
      u32x4 pk; pk.x = pk2(sT[2 * sg][0], sT[2 * sg][1]); pk.y = pk2(sT[2 * sg][2], sT[2 * sg][3]); pk.z = pk2(sT[2 * sg + 1][0], sT[2 * sg + 1][1]); pk.w = pk2(sT[2 * sg + 1][2], sT[2 * sg + 1][3]);
      const s16x8 pf = __builtin_bit_cast(s16x8, pk);
#pragma unroll
      for (int nv = 0; nv < 3; ++nv) hI[nv] = __builtin_amdgcn_mfma_f32_16x16x32_bf16(pf, vf[nv][sg], hI[nv], 0, 0, 0);
    }
#pragma unroll
    for (int ks = 0; ks < 4; ++ks)
#pragma unroll
      for (int nv = 0; nv < 3; ++nv) { const s16x8 cf = *(const s16x8*)(Ct + (16 * nv + lr) * 136 + 32 * ks + 8 * g); hC[nv] = __builtin_amdgcn_mfma_f32_16x16x32_bf16(qf[ks], cf, hC[nv], 0, 0, 0); }
    {
      const f32x4 av4 = *(const f32x4*)(avec + 16 * w + 4 * g);
#pragma unroll
      for (int i = 0; i < 4; ++i) {
        const float den = hI[2][i] + av4[i] * hC[2][i];
        const float dn = shl_(den, lane & 48);
        const float inv = 1.f / fmaxf(fabsf(dn), 1.f);
#pragma unroll
        for (int nv = 0; nv < 2; ++nv) hdir[(R0 + 16 * w + 4 * g + i) * 1024 + h * 256 + v0 + 16 * nv + lr] = f2bf((hI[nv][i] + av4[i] * hC[nv][i]) * inv);
      }
    }
    {
      const float ef = eFs[0];
#pragma unroll
      for (int a = 0; a < 2; ++a) {
#pragma unroll
        for (int nv = 0; nv < 3; ++nv) Cacc[a][nv] = Cacc[a][nv] * ef;
#pragma unroll
        for (int sg = 0; sg < 2; ++sg) {
          const u32x2 klo = *(const u32x2*)(KWt + (16 * (2 * w + a) + lr) * LDT + 32 * sg + 4 * g), khi = *(const u32x2*)(KWt + (16 * (2 * w + a) + lr) * LDT + 32 * sg + 16 + 4 * g);
          u32x4 kk; kk.x = klo.x; kk.y = klo.y; kk.z = khi.x; kk.w = khi.y; const s16x8 kw = __builtin_bit_cast(s16x8, kk);
#pragma unroll
          for (int nv = 0; nv < 3; ++nv) Cacc[a][nv] = __builtin_amdgcn_mfma_f32_16x16x32_bf16(kw, vf[nv][sg], Cacc[a][nv], 0, 0, 0);
        }
      }
    }
  }
}

#define YA_DST(P, l) slot(P, 7)
__device__ void attn_unit(const Params& P, int layer_, int u, int half, char* smc) {
  constexpr int LDV = 68;
  bf16_t* Ksm = (bf16_t*)smc;
  bf16_t* Vsm = Ksm + 64 * 136;
  const int tid = otid(), lane = tid & 63, w = tid >> 6, r = lane & 31, h = lane >> 5;
  int b, head, pq0, nkeys;
  if (u < 1024) { b = u >> 9; head = (u >> 6) & 7; pq0 = NCTX + 128 * (u & 63); nkeys = PB; }
  else { const int v = u - 1024; b = v >> 4; head = (v >> 1) & 7; pq0 = 128 * (v & 1); nkeys = NCTX; }
  const int kvh = head >> 2;
  const int kbeg = half > 0 ? half * (PB / 4) : 0, kend = half >= 0 ? (half + 1) * (PB / 4) : nkeys;
  bf16_t* aq = slot(P, 7);
  const bf16_t* ak = slot(P, 4) + (size_t)TR * 512; const bf16_t* avT = ak + (size_t)TR * 256;
  constexpr int ABUF = 64 * 136 + 128 * LDV;
  s16x8 qf[8];
#pragma unroll
  for (int ks = 0; ks < 8; ++ks) qf[ks] = *(const s16x8*)(aq + (size_t)(b * PB + pq0 + 32 * w + r) * 1024 + head * 128 + 16 * ks + 8 * h);
  f32x16 O[4];
#pragma unroll
  for (int d = 0; d < 4; ++d)
#pragma unroll
    for (int e = 0; e < 16; ++e) O[d][e] = 0.f;
  float mrun = 0.f, lrun = 0.f;
  f32x16 cinit;
#pragma unroll
  for (int e = 0; e < 16; ++e) cinit[e] = 0.f;
  const int k_r = tid >> 4, k_c = (tid & 15) * 8, v_d = tid >> 3, v_c = (tid & 7) * 8;
  const bf16_t* kp = ak + (size_t)(b * PB + kbeg + k_r) * 256 + kvh * 128 + k_c;
  const bf16_t* vp = avT + (size_t)(b * 256 + kvh * 128 + v_d) * PB + kbeg + v_c;
  const int nkt = kend - kbeg;
  u32x4 rk[4], rv[4];
  auto stage = [&](bf16_t* Kd, bf16_t* Vd) {
#pragma unroll
    for (int i = 0; i < 4; ++i) {
      *(u32x4*)(Kd + (k_r + 16 * i) * 136 + k_c) = rk[i];
      u32x2 lo, hi; lo.x = rv[i].x; lo.y = rv[i].y; hi.x = rv[i].z; hi.y = rv[i].w;
      *(u32x2*)(Vd + (v_d + 32 * i) * LDV + v_c) = lo; *(u32x2*)(Vd + (v_d + 32 * i) * LDV + v_c + 4) = hi;
    }
  };
#pragma unroll
  for (int i = 0; i < 4; ++i) { rk[i] = *(const u32x4*)(kp + (size_t)(16 * i) * 256); rv[i] = *(const u32x4*)(vp + (size_t)(32 * i) * PB); }
  __syncthreads();
  stage(Ksm, Vsm);
  if (64 < nkt) {
#pragma unroll
    for (int i = 0; i < 4; ++i) { rk[i] = *(const u32x4*)(kp + (size_t)(64 + 16 * i) * 256); rv[i] = *(const u32x4*)(vp + (size_t)(32 * i) * PB + 64); }
  }
  __syncthreads();
  for (int k0 = 0; k0 < nkt; k0 += 64) {
    const int cb = (k0 >> 6) & 1;
    const bf16_t* Kc = Ksm + cb * ABUF; const bf16_t* Vc = Vsm + cb * ABUF;
    if (k0 + 64 < nkt) {
      stage(Ksm + (cb ^ 1) * ABUF, Vsm + (cb ^ 1) * ABUF);
      if (k0 + 128 < nkt) {
#pragma unroll
        for (int i = 0; i < 4; ++i) { rk[i] = *(const u32x4*)(kp + (size_t)(k0 + 128 + 16 * i) * 256); rv[i] = *(const u32x4*)(vp + (size_t)(32 * i) * PB + k0 + 128); }
      }
    }
    f32x16 S[2];
#pragma unroll
    for (int ks = 0; ks < 8; ++ks)
#pragma unroll
      for (int m = 0; m < 2; ++m) {
        const s16x8 kf = *(const s16x8*)(Kc + (32 * m + r) * 136 + 16 * ks + 8 * h);
        S[m] = __builtin_amdgcn_mfma_f32_32x32x16_bf16(kf, qf[ks], ks == 0 ? cinit : S[m], 0, 0, 0);
      }
    __builtin_amdgcn_sched_barrier(0);
    float mx = -1e30f;
#pragma unroll
    for (int m = 0; m < 2; ++m)
#pragma unroll
      for (int e = 0; e < 16; ++e) mx = fmaxf(mx, S[m][e]);
    mx = fmaxf(mx, shx(mx, 32, lane));
    if (__builtin_amdgcn_ballot_w64(mx > 8.f) != 0ull) {
      const float dlt = fmaxf(mx, 0.f), alpha = __builtin_amdgcn_exp2f(-dlt);
      mrun += dlt; lrun *= alpha;
#pragma unroll
      for (int d = 0; d < 4; ++d) O[d] = O[d] * alpha;
#pragma unroll
      for (int m = 0; m < 2; ++m)
#pragma unroll
        for (int e = 0; e < 16; ++e) S[m][e] -= dlt;
#pragma unroll
      for (int e = 0; e < 16; ++e) cinit[e] = -mrun;
    }
    float ls = 0.f;
#pragma unroll
    for (int m = 0; m < 2; ++m)
#pragma unroll
      for (int e = 0; e < 16; ++e) { const float pv = __builtin_amdgcn_exp2f(S[m][e]); S[m][e] = pv; ls += pv; }
    lrun += ls;
    s16x8 pf[2][2];
#pragma unroll
    for (int m = 0; m < 2; ++m)
#pragma unroll
      for (int sg = 0; sg < 2; ++sg) {
        u32x4 pk; pk.x = pk2(S[m][8 * sg + 0], S[m][8 * sg + 1]); pk.y = pk2(S[m][8 * sg + 2], S[m][8 * sg + 3]);
        pk.z = pk2(S[m][8 * sg + 4], S[m][8 * sg + 5]); pk.w = pk2(S[m][8 * sg + 6], S[m][8 * sg + 7]);
        pf[m][sg] = __builtin_bit_cast(s16x8, pk);
      }
    __builtin_amdgcn_sched_barrier(0);
#pragma unroll
    for (int m = 0; m < 2; ++m)
#pragma unroll
      for (int sg = 0; sg < 2; ++sg)
#pragma unroll
        for (int d = 0; d < 4; ++d) {
          const u32x2 lo = *(const u32x2*)(Vc + (32 * d + r) * LDV + 32 * m + 16 * sg + 4 * h);
          const u32x2 hi = *(const u32x2*)(Vc + (32 * d + r) * LDV + 32 * m + 16 * sg + 8 + 4 * h);
          u32x4 vv; vv.x = lo.x; vv.y = lo.y; vv.z = hi.x; vv.w = hi.y;
          O[d] = __builtin_amdgcn_mfma_f32_32x32x16_bf16(__builtin_bit_cast(s16x8, vv), pf[m][sg], O[d], 0, 0, 0);
        }
    __syncthreads();
  }
  {
    float l = lrun; l += shx(l, 32, lane);
    const float inv = 1.f / l;
    const int rrow = 32 * w + r;
    bf16_t* op = YA_DST(P, layer_) + (size_t)(b * PB + pq0 + rrow) * 1024 + head * 128 + 4 * h;
    if (half >= 0) {
      const int su = u - 896;
      op = (bf16_t*)(P.ws + OFF_PO) + ((size_t)(half * 128 + su) * 128 + rrow) * 128 + 4 * h;
      if (h == 0) ((f32x2*)(P.ws + OFF_ML))[(size_t)(half * 128 + su) * 128 + rrow] = (f32x2){mrun, l};
    }
#pragma unroll
    for (int d = 0; d < 4; ++d)
#pragma unroll
      for (int q = 0; q < 4; ++q) { u32x2 o; o.x = pk2(O[d][4 * q] * inv, O[d][4 * q + 1] * inv); o.y = pk2(O[d][4 * q + 2] * inv, O[d][4 * q + 3] * inv); *(u32x2*)(op + 32 * d + 8 * q) = o; }
  }
}

__device__ void phase_mix(const Params& P, int layer, char* smc) {
  for (int wg = blockIdx.x; wg < 128; wg += gridDim.x) mlstm_run(P, wg, smc);
  unsigned* cnt = (unsigned*)(P.ws + OFF_CNT) + layer;
  int* ubox = (int*)(smc + 74496);
  const int NUX = 896 + 512 + ((layer == 0) ? 32 : 0);
  for (;;) {
    __syncthreads();
    if (otid() == 0) ubox[0] = (int)atomicAdd(cnt, 1u);
    __syncthreads();
    const int it = ubox[0];
    if (it >= NUX) break;
    if (it < 896) attn_unit(P, layer, it, -1, smc);
    else if (it < 1408) attn_unit(P, layer, 896 + ((it - 896) >> 2), (it - 896) & 3, smc);
    else attn_unit(P, layer, 1024 + (it - 1408), -1, smc);
  }
}

__device__ void phase_fin(const Params& P, int layer) {
  const int tid = otid(), lane = tid & 63, w = tid >> 6;
  bf16_t* hf = slot(P, 1); const bf16_t* hb = slot(P, 0); const bf16_t* mo = slot(P, 6); bf16_t* h1n = slot(P, 3);
  const float* gain = P.mnorm + layer * 1024; const float* gvec = P.norm1 + layer * 1024;
  for (int R = blockIdx.x * 4 + w; R < TR; R += gridDim.x * 4) {
    const int b = R / PB, p = R - b * PB;
    if (layer == 1 && p < NCTX) continue;
    const int col = lane * 16;
    u32x4 ha[2], hc[2], og[2]; f32x4 gn[4];
#pragma unroll
    for (int q = 0; q < 2; ++q) { ha[q] = *(const u32x4*)(hf + (size_t)R * 1024 + col + 8 * q); hc[q] = *(const u32x4*)(hb + (size_t)R * 1024 + col + 8 * q); og[q] = *(const u32x4*)(mo + (size_t)R * 1024 + col + 8 * q); }
#pragma unroll
    for (int q = 0; q < 4; ++q) gn[q] = *(const f32x4*)(gain + col + 4 * q);
    const float* xr = xsrc_row(P, layer == 0, R);
    const float* mod = (const float*)(P.ws + OFF_MOD) + (size_t)(layer * 3 + (p < NCTX ? 2 : b)) * 6144;
    f32x4 xv[4], gv4[4], sh4[4], sc4[4];
#pragma unroll
    for (int i = 0; i < 4; ++i) { const int c4 = 256 * i + lane * 4; xv[i] = *(const f32x4*)(xr + c4); gv4[i] = *(const f32x4*)(gvec + c4); sh4[i] = *(const f32x4*)(mod + c4); sc4[i] = *(const f32x4*)(mod + 1024 + c4); }
    const bool split = (b == 1 && p >= NCTX && lane < 32);
    f32x2 ml[4]; u32x4 pa[4];
    if (split) {
      const int sl = p - NCTX, qb = sl >> 7, r = sl & 127, hd = lane >> 4, su = hd * 64 + qb;
      const f32x2* mlp = (const f32x2*)(P.ws + OFF_ML); const bf16_t* po = (const bf16_t*)(P.ws + OFF_PO);
#pragma unroll
      for (int q = 0; q < 4; ++q) { ml[q] = mlp[(size_t)(q * 128 + su) * 128 + r]; pa[q] = *(const u32x4*)(po + ((size_t)(q * 128 + su) * 128 + r) * 128 + (lane & 15) * 8); }
    }
    float v[16]; float ss = 0.f;
#pragma unroll
    for (int q = 0; q < 2; ++q)
#pragma unroll
      for (int e = 0; e < 4; ++e) { v[8 * q + 2 * e] = bflo(ha[q][e]) + bflo(hc[q][e]); v[8 * q + 2 * e + 1] = bfhi(ha[q][e]) + bfhi(hc[q][e]); }
#pragma unroll
    for (int e = 0; e < 16; ++e) ss += v[e] * v[e];
    ss += shx(ss, 1, lane); ss += shx(ss, 2, lane); ss += shx(ss, 4, lane); ss += shx(ss, 8, lane);
    const float rstd = rsqrtf(ss * (1.f / 256.f) + EPS);
    u32x4 ym[2];
#pragma unroll
    for (int q = 0; q < 2; ++q)
#pragma unroll
      for (int e = 0; e < 4; ++e) {
        const float lo = v[8 * q + 2 * e] * rstd * gn[2 * q + (e >> 1)][(2 * e) & 3] * sigmoidf_(bflo(og[q][e]));
        const float hi = v[8 * q + 2 * e + 1] * rstd * gn[2 * q + (e >> 1)][(2 * e + 1) & 3] * sigmoidf_(bfhi(og[q][e]));
        ym[q][e] = pk2(lo, hi);
      }
    float s2 = 0.f;
#pragma unroll
    for (int i = 0; i < 4; ++i) s2 += xv[i][0] * xv[i][0] + xv[i][1] * xv[i][1] + xv[i][2] * xv[i][2] + xv[i][3] * xv[i][3];
#pragma unroll
    for (int o = 32; o >= 1; o >>= 1) s2 += shx(s2, o, lane);
    const float rstd2 = rsqrtf(s2 * (1.f / 1024.f) + EPS);
    u32x2 hq[4];
#pragma unroll
    for (int i = 0; i < 4; ++i) {
#pragma unroll
      for (int e = 0; e < 4; ++e) xv[i][e] = (xv[i][e] * rstd2 * gv4[i][e]) * (1.f + sc4[i][e]) + sh4[i][e];
      hq[i].x = pk2(xv[i][0], xv[i][1]); hq[i].y = pk2(xv[i][2], xv[i][3]);
    }
#pragma unroll
    for (int q = 0; q < 2; ++q) *(u32x4*)(hf + (size_t)R * 1024 + col + 8 * q) = ym[q];
#pragma unroll
    for (int i = 0; i < 4; ++i) *(u32x2*)(h1n + (size_t)R * 1024 + 256 * i + lane * 4) = hq[i];
    if (split) {
      float mm = -1e30f;
#pragma unroll
      for (int q = 0; q < 4; ++q) mm = fmaxf(mm, ml[q].x);
      float wq[4], ws_ = 0.f;
#pragma unroll
      for (int q = 0; q < 4; ++q) { wq[q] = ml[q].y * __builtin_amdgcn_exp2f(ml[q].x - mm); ws_ += wq[q]; }
      const float inv = 1.f / ws_;
      float o8[8];
#pragma unroll
      for (int e = 0; e < 8; ++e) o8[e] = 0.f;
#pragma unroll
      for (int q = 0; q < 4; ++q) {
        const float wv = wq[q] * inv;
#pragma unroll
        for (int e = 0; e < 4; ++e) { o8[2 * e] += bflo(pa[q][e]) * wv; o8[2 * e + 1] += bfhi(pa[q][e]) * wv; }
      }
      u32x4 o;
#pragma unroll
      for (int e = 0; e < 4; ++e) o[e] = pk2(o8[2 * e], o8[2 * e + 1]);
      *(u32x4*)(YA_DST(P, layer) + (size_t)R * 1024 + 768 + lane * 8) = o;
    }
  }
}

template <int MW, int NT>
__device__ __forceinline__ void merge_tile(const Params& P, int layer, int R0, int nt_, bf16_t* sm) {
  const int tid = otid(), lane = tid & 63, w = tid >> 6, r = lane & 31, h = lane >> 5;
  constexpr int NQ = NT / 2, LDW = 16 * NT + 8;
  const bf16_t* h1n = slot(P, 3); bf16_t* merged = slot(P, 4);
  f32x16 mer[MW / 2][NQ]; zero_acc<MW, NT>(mer);
#pragma unroll 1
  for (int br = 0; br < 3; ++br) {
    f32x16 ga[MW / 2][NQ]; zero_acc<MW, NT>(ga);
    gemm_core<MW, NT>(h1n + (size_t)R0 * 1024, 1024, wbuf(P, W_IN) + (size_t)(7680 + 1024 * br + 16 * NT * nt_) * 1024, 1024, 1024, ga, sm);
    unsigned gp[MW / 2][NQ][8];
#pragma unroll
    for (int m = 0; m < MW / 2; ++m)
#pragma unroll
      for (int n = 0; n < NQ; ++n)
#pragma unroll
        for (int k = 0; k < 8; ++k) gp[m][n][k] = pk2(sigmoidf_(ga[m][n][2 * k]), sigmoidf_(ga[m][n][2 * k + 1]));
    f32x16 ya[MW / 2][NQ]; zero_acc<MW, NT>(ya);
    const bf16_t* yb = br == 1 ? YA_DST(P, layer) : slot(P, br == 0 ? 1 : 2);
    gemm_core<MW, NT>(yb + (size_t)R0 * 1024, 1024, wbuf(P, W_PM + (size_t)br * 2097152) + (size_t)(16 * NT * nt_) * 1024, 1024, 1024, ya, sm);
#pragma unroll
    for (int m = 0; m < MW / 2; ++m)
#pragma unroll
      for (int n = 0; n < NQ; ++n)
#pragma unroll
        for (int k = 0; k < 8; ++k) { mer[m][n][2 * k] += bflo(gp[m][n][k]) * ya[m][n][2 * k]; mer[m][n][2 * k + 1] += bfhi(gp[m][n][k]) * ya[m][n][2 * k + 1]; }
  }
  bf16_t* smw = sm + w * 32 * LDW;
#pragma unroll
  for (int m = 0; m < MW / 2; ++m) {
#pragma unroll
    for (int q = 0; q < 4; ++q)
#pragma unroll
      for (int i = 0; i < 4; ++i)
#pragma unroll
        for (int n = 0; n < NQ; ++n) smw[(8 * q + 4 * h + i) * LDW + 32 * n + r] = f2bf(mer[m][n][4 * q + i]);
    flush_pass<NT>(smw, merged + (size_t)(R0 + 16 * MW * w + 32 * m) * 1024 + 16 * NT * nt_, 1024, lane);
  }
}
__device__ void phase_merge(const Params& P, int layer, char* smc) {
  bf16_t* sm = (bf16_t*)smc;
  const int x = blockIdx.x & 7, loc = blockIdx.x >> 3, nloc = gridDim.x >> 3;
  for (int j = loc; j < 128; j += nloc) {
    const int jl = j & 63, mt = 16 * x + 8 * (j >> 6) + ((jl >> 1) & 7), nt = (jl & 1) | ((jl >> 4) << 1);
    merge_tile<2, 8>(P, layer, (mt >> 6) * PB + NCTX + (mt & 63) * 128, nt, sm);
  }
  if (layer == 0)
    for (int k = loc;; k += nloc) { const int sidx = x + 8 * k; if (sidx >= 64) break; merge_tile<2, 4>(P, layer, small_R0(sidx >> 4), sidx & 15, sm); }
}

template <int MW>
__device__ __forceinline__ void resid_tile(const Params& P, int layer, const bf16_t* A, int lda, int K, const bf16_t* Wt, int modchunk, bool srcInput, int R0, int nt_, bf16_t* sm, int kofs = 0, int klen = 0) {
  const int tid = otid(), lane = tid & 63, w = tid >> 6, r = lane & 31, h = lane >> 5;
  f32x16 acc[MW / 2][4]; zero_acc<MW, 8>(acc);
  gemm_core<MW, 8>(A + (size_t)R0 * lda + kofs, lda, Wt + (size_t)nt_ * 128 * K + kofs, K, klen ? klen : K, acc, sm);
  const float* gate = modrow(P, layer, R0) + modchunk * 1024 + nt_ * 128;
  float gv[4];
#pragma unroll
  for (int n = 0; n < 4; ++n) gv[n] = gate[32 * n + r];
  if (klen) {
#pragma unroll
    for (int m = 0; m < MW / 2; ++m)
#pragma unroll
      for (int q = 0; q < 4; ++q)
#pragma unroll
        for (int i = 0; i < 4; ++i) {
          float* xd = xdst_row(P, R0 + 16 * MW * w + 32 * m + 8 * q + 4 * h + i) + nt_ * 128;
#pragma unroll
          for (int n = 0; n < 4; ++n) atomicAdd(xd + 32 * n + r, gv[n] * acc[m][n][4 * q + i]);
        }
    return;
  }
  constexpr int NR = 8 * MW;
  float xin[2][4];
  {
    const float* xs = xsrc_row(P, srcInput, R0 + 16 * MW * w + 4 * h) + nt_ * 128;
#pragma unroll
    for (int n = 0; n < 4; ++n) xin[0][n] = xs[32 * n + r];
  }
#pragma unroll
  for (int j = 0; j < NR; ++j) {
    const int m = j >> 4, q = (j >> 2) & 3, i = j & 3;
    const int R = R0 + 16 * MW * w + 32 * m + 8 * q + 4 * h + i;
    if (j + 1 < NR) {
      const int jn = j + 1, Rn = R0 + 16 * MW * w + 32 * (jn >> 4) + 8 * ((jn >> 2) & 3) + 4 * h + (jn & 3);
      const float* xs = xsrc_row(P, srcInput, Rn) + nt_ * 128;
#pragma unroll
      for (int n = 0; n < 4; ++n) xin[(j + 1) & 1][n] = xs[32 * n + r];
    }
    float* xd = xdst_row(P, R) + nt_ * 128;
#pragma unroll
    for (int n = 0; n < 4; ++n) xd[32 * n + r] = xin[j & 1][n] + gv[n] * acc[m][n][4 * q + i];
  }
}
__device__ void phase_resid(const Params& P, int layer, const bf16_t* A, int lda, int K, const bf16_t* Wt, int modchunk, bool srcInput, char* smc) {
  bf16_t* sm = (bf16_t*)smc;
  const int x = blockIdx.x & 7, loc = blockIdx.x >> 3, nloc = gridDim.x >> 3, nks = K >> 7;
  for (int j = loc; j < 64; j += nloc) resid_tile<4>(P, layer, A, lda, K, Wt, modchunk, srcInput, big_R0(8 * x + ((j >> 1) & 7)), (j & 1) | ((j >> 4) << 1), sm);
  if (layer == 0)
    for (int q = blockIdx.x; q < 32 * nks; q += gridDim.x) { const int t = q / nks, ks = q - t * nks; resid_tile<2>(P, layer, A, lda, K, Wt, modchunk, false, small_R0(t >> 3), t & 7, sm, ks * 128, 128); }
}

template <int MW>
__device__ __forceinline__ void up_tile(const Params& P, int R0, int nt_, bf16_t* sm) {
  const int tid = otid(), lane = tid & 63, w = tid >> 6, r = lane & 31, h = lane >> 5;
  const bf16_t* h2 = slot(P, 0); bf16_t* U = slot(P, 3);
  f32x16 acc[MW / 2][4]; zero_acc<MW, 8>(acc);
  gemm_core<MW, 8>(h2 + (size_t)R0 * 1024, 1024, wbuf(P, W_UP) + (size_t)nt_ * 128 * 1024, 1024, 1024, acc, sm);
  bf16_t* smw = sm + w * 32 * 136;
#pragma unroll
  for (int m = 0; m < MW / 2; ++m) {
#pragma unroll
    for (int q = 0; q < 4; ++q)
#pragma unroll
      for (int i = 0; i < 4; ++i)
#pragma unroll
        for (int n = 0; n < 4; ++n) { const float v = fmaxf(acc[m][n][4 * q + i], 0.f); smw[(8 * q + 4 * h + i) * 136 + 32 * n + r] = f2bf(v * v); }
    flush_pass<8>(smw, U + (size_t)(R0 + 16 * MW * w + 32 * m) * 4096 + nt_ * 128, 4096, lane);
  }
}
__device__ void phase_up(const Params& P, int layer, char* smc) {
  bf16_t* sm = (bf16_t*)smc;
  for (int i = 0;; ++i) {
    bool big; int R0, nt;
    if (!gemm_unit(i, 32, layer == 0, big, R0, nt)) break;
    if (big) up_tile<4>(P, R0, nt, sm); else up_tile<2>(P, R0, nt, sm);
  }
}

__device__ void phase_fnorm(const Params& P) {
  const int tid = otid(), lane = tid & 63, w = tid >> 6;
  const int rstride = gridDim.x * 4;
  f32x4 xn[4], gfn[4];
#pragma unroll
  for (int i = 0; i < 4; ++i) gfn[i] = *(const f32x4*)(P.fnorm + 256 * i + lane * 4);
  int r = blockIdx.x * 4 + w;
  if (r < 2 * SEQ) {
#pragma unroll
    for (int i = 0; i < 4; ++i) xn[i] = *(const f32x4*)(P.out + (size_t)r * 1024 + 256 * i + lane * 4);
  }
  for (; r < 2 * SEQ; r += rstride) {
    float* xr = P.out + (size_t)r * 1024;
    f32x4 xv[4]; float ss = 0.f;
#pragma unroll
    for (int i = 0; i < 4; ++i) { xv[i] = xn[i]; ss += xv[i][0] * xv[i][0] + xv[i][1] * xv[i][1] + xv[i][2] * xv[i][2] + xv[i][3] * xv[i][3]; }
    if (r + rstride < 2 * SEQ) {
#pragma unroll
      for (int i = 0; i < 4; ++i) xn[i] = *(const f32x4*)(P.out + (size_t)(r + rstride) * 1024 + 256 * i + lane * 4);
    }
#pragma unroll
    for (int o = 32; o >= 1; o >>= 1) ss += shx(ss, o, lane);
    const float rstd = rsqrtf(ss * (1.f / 1024.f) + EPS);
#pragma unroll
    for (int i = 0; i < 4; ++i) { f32x4 o;
#pragma unroll
      for (int e = 0; e < 4; ++e) o[e] = xv[i][e] * rstd * gfn[i][e];
      *(f32x4*)(xr + 256 * i + lane * 4) = o; }
  }
}

constexpr int LDS_BYTES = 74752;
constexpr int NPHASE = 22;
__device__ void run_phase(const Params& P, int ph, char* sm) {
  if (ph == 0) { phase_prologue(P, sm); return; }
  if (ph == 21) { phase_fnorm(P); return; }
  const int layer = (ph - 1) / 10, k = (ph - 1) % 10;
  switch (k) {
    case 0: phase_norm(P, layer, 0, sm); break;
    case 1: phase_inproj(P, layer, sm); break;
    case 2: phase_conv(P, layer); break;
    case 3: phase_mix(P, layer, sm); break;
    case 4: phase_fin(P, layer); break;
    case 5: phase_merge(P, layer, sm); break;
    case 6: phase_resid(P, layer, slot(P, 4), 1024, 1024, wbuf(P, W_O), 2, layer == 0, sm); break;
    case 7: phase_norm(P, layer, 1, sm); break;
    case 8: phase_up(P, layer, sm); break;
    default: phase_resid(P, layer, slot(P, 3), 4096, 4096, wbuf(P, W_DN), 5, false, sm); break;
  }
}

__device__ __forceinline__ void grid_barrier(char* ws, unsigned gen) {
  asm volatile("s_waitcnt vmcnt(0)" ::: "memory");
  __syncthreads();
  unsigned* flags = (unsigned*)(ws + OFF_CNT + 1024); unsigned* rel = (unsigned*)(ws + OFF_CNT + 3584);
  const int tid = otid();
  if (tid < 64) {
    __builtin_amdgcn_fence(__ATOMIC_RELEASE, "agent");
    if (blockIdx.x == 0) {
      for (;;) {
        bool ok = true;
#pragma unroll
        for (int j = 0; j < 8; ++j) { const int idx = tid + 64 * j; if (idx != 0 && idx < (int)gridDim.x) { if (__hip_atomic_load(flags + idx, __ATOMIC_RELAXED, __HIP_MEMORY_SCOPE_AGENT) < gen) ok = false; } }
        if (__builtin_amdgcn_ballot_w64(!ok) == 0ull) break;
        __builtin_amdgcn_s_sleep(1);
      }
      if (tid == 0) __hip_atomic_store(rel, gen, __ATOMIC_RELAXED, __HIP_MEMORY_SCOPE_AGENT);
    } else if (tid == 0) {
      __hip_atomic_store(flags + blockIdx.x, gen, __ATOMIC_RELAXED, __HIP_MEMORY_SCOPE_AGENT);
      while (__hip_atomic_load(rel, __ATOMIC_RELAXED, __HIP_MEMORY_SCOPE_AGENT) < gen) __builtin_amdgcn_s_sleep(1);
    }
    __builtin_amdgcn_fence(__ATOMIC_ACQUIRE, "agent");
  }
  __syncthreads();
}

__global__ void __launch_bounds__(256, 2) mega(Params P, int ph0, int ph1, int coop) {
  extern __shared__ __attribute__((aligned(16))) char smem[];
  unsigned gen = 0;
  const int npre = 0;
  const int nit = npre + (ph1 - ph0);
  for (int it = 0; it < nit; ++it) {
    const int ph = it < npre ? it : ph0 + (it - npre);
    run_phase(P, ph, smem);
    if (coop && it + 1 < nit) {
      if (it == 0) cg::this_grid().sync();
      else grid_barrier(P.ws, ++gen);
    }
  }
}

extern "C" void kernel_launch(void* const* d_in, const int* in_sizes, int n_in, void* d_out, int out_size, void* d_ws, size_t ws_size, hipStream_t stream) {
  static int grid = 0;
  if (grid == 0) {
    if (n_in != 21 || ws_size < WS_NEED) { fprintf(stderr, "kernel_launch: need 21 inputs and %zu bytes of workspace; got %d, %zu\n", (size_t)WS_NEED, n_in, ws_size); grid = -1; return; }
    int dev = 0, cus = 0, per_cu = 0;
    hipGetDevice(&dev);
    hipDeviceGetAttribute(&cus, hipDeviceAttributeMultiprocessorCount, dev);
    if (hipFuncSetAttribute((const void*)mega, hipFuncAttributeMaxDynamicSharedMemorySize, LDS_BYTES) != hipSuccess) { fprintf(stderr, "kernel_launch: hipFuncSetAttribute failed\n"); grid = -1; return; }
    if (hipOccupancyMaxActiveBlocksPerMultiprocessor(&per_cu, (const void*)mega, 256, LDS_BYTES) != hipSuccess || per_cu < 1) { fprintf(stderr, "kernel_launch: occupancy query failed (%d)\n", per_cu); per_cu = 1; }
    if (per_cu > 2) per_cu = 2;
    grid = cus * per_cu;
    fprintf(stderr, "kernel_launch: grid %d (%d CUs x %d)\n", grid, cus, per_cu);
  }
  if (grid < 0) return;
  hipMemsetAsync((char*)d_ws + OFF_CNT, 0, 4096, stream);
  Params p{};
  const float** pp = (const float**)&p;
  for (int i = 0; i < 21; ++i) pp[i] = (const float*)d_in[i];
  p.out = (float*)d_out; p.ws = (char*)d_ws;
#if MULTI_LAUNCH
  for (int ph = 0; ph < NPHASE; ++ph) hipLaunchKernelGGL(mega, dim3(grid), dim3(256), LDS_BYTES, stream, p, ph, ph + 1, 0);
#else
  int ph0 = 0, ph1 = NPHASE, coop = 1;
  void* args[] = {&p, &ph0, &ph1, &coop};
  hipError_t e = hipLaunchCooperativeKernel((const void*)mega, dim3(grid), dim3(256), args, LDS_BYTES, stream);
  if (e != hipSuccess) fprintf(stderr, "cooperative launch failed: %s (grid %d)\n", hipGetErrorString(e), grid);
#endif
}
```

```cpp
#include <hip/hip_runtime.h>
#include <hip/hip_cooperative_groups.h>
#include <cstdio>
#include <cstdint>
namespace cg = cooperative_groups;

#ifndef MULTI_LAUNCH
#define MULTI_LAUNCH 0
#endif

typedef unsigned short bf16_t;
typedef short s16x8 __attribute__((ext_vector_type(8)));
typedef short s16x4 __attribute__((ext_vector_type(4)));
typedef float f32x4 __attribute__((ext_vector_type(4)));
typedef float f32x2 __attribute__((ext_vector_type(2)));
typedef unsigned u32x4 __attribute__((ext_vector_type(4)));
typedef unsigned u32x2 __attribute__((ext_vector_type(2)));

constexpr int D = 1024, TR = 16896, PB = 8448, NCTX = 256, SEQ = 8192, INC = 10768, DFF = 4096;
constexpr int NMT = TR / 128;
constexpr float EPS = 1e-6f;
constexpr float QSCALE = 0.08838834764831845f * 1.4426950408889634f;
constexpr float MQSCALE = 0.08838834764831845f;

constexpr size_t E1 = (size_t)TR * 1024 * 2;
constexpr size_t OFF_CNT = 0;
constexpr size_t OFF_ROPE = 4096;
constexpr size_t OFF_MOD = OFF_ROPE + 128 * 32 * 8;
constexpr size_t OFF_GATES = OFF_MOD + 2 * 3 * 6144 * 4;
constexpr size_t OFF_CTXB = OFF_GATES + (size_t)TR * 16 * 4;
constexpr size_t OFF_W = OFF_CTXB + (size_t)512 * 1024 * 4;
constexpr size_t W_IN = 0, W_PM = W_IN + (size_t)10752 * 1024 * 2, W_PA = W_PM + 2097152, W_PC = W_PA + 2097152, W_O = W_PC + 2097152,
                 W_UP = W_O + 2097152, W_DN = W_UP + 8388608, W_END = W_DN + 8388608;
constexpr size_t OFF_S = OFF_W + W_END;
constexpr size_t OFF_PO = OFF_S + 8 * E1;
constexpr size_t OFF_ML = OFF_PO + (size_t)2 * 256 * 128 * 128 * 2;
constexpr size_t OFF_GW = OFF_ML + (size_t)2 * 256 * 128 * 8;
constexpr size_t WS_NEED = OFF_GW + (size_t)2 * 16 * 1024 * 4;

struct Params {
  const float *x, *c, *ctx, *c_ctx, *w_ada, *b_ada, *norm1, *norm2, *w_in, *gate_b, *mnorm, *qn, *kn, *conv_w, *wpm, *wpa, *wpc, *wout, *wup, *wdn, *fnorm;
  float* out; char* ws;
};

__device__ __forceinline__ int otid() { int t = threadIdx.x; asm volatile("" : "+v"(t)); return t; }
__device__ __forceinline__ float shx(float x, int m, int lane) { return __builtin_bit_cast(float, __builtin_amdgcn_ds_bpermute((lane ^ m) << 2, __builtin_bit_cast(int, x))); }
__device__ __forceinline__ float shl_(float x, int src) { return __builtin_bit_cast(float, __builtin_amdgcn_ds_bpermute(src << 2, __builtin_bit_cast(int, x))); }
__device__ __forceinline__ bf16_t* slot(const Params& P, int s) { return (bf16_t*)(P.ws + OFF_S + (size_t)s * E1); }
__device__ __forceinline__ bf16_t* wbuf(const Params& P, size_t off) { return (bf16_t*)(P.ws + OFF_W + off); }

__device__ __forceinline__ unsigned pk2(float lo, float hi) { unsigned r; asm("v_cvt_pk_bf16_f32 %0, %1, %2" : "=v"(r) : "v"(lo), "v"(hi)); return r; }
__device__ __forceinline__ bf16_t f2bf(float f) { return (bf16_t)(pk2(f, f) & 0xffffu); }
__device__ __forceinline__ float bflo(unsigned u) { return __uint_as_float(u << 16); }
__device__ __forceinline__ float bfhi(unsigned u) { return __uint_as_float(u & 0xffff0000u); }
__device__ __forceinline__ float sigmoidf_(float x) { return 1.f / (1.f + __expf(-x)); }

__device__ __forceinline__ const float* xsrc_row(const Params& P, bool useInput, int R) {
  const int b = R / PB, p = R - b * PB;
  if (p < NCTX) return (useInput ? P.ctx : (const float*)(P.ws + OFF_CTXB)) + (size_t)(b * NCTX + p) * D;
  return (useInput ? P.x : (const float*)P.out) + (size_t)(b * SEQ + p - NCTX) * D;
}
__device__ __forceinline__ float* xdst_row(const Params& P, int R) {
  const int b = R / PB, p = R - b * PB;
  if (p < NCTX) return (float*)(P.ws + OFF_CTXB) + (size_t)(b * NCTX + p) * D;
  return P.out + (size_t)(b * SEQ + p - NCTX) * D;
}
__device__ __forceinline__ const float* modrow(const Params& P, int layer, int R0) {
  const int b = R0 / PB, p = R0 - b * PB;
  const int mi = (p < NCTX) ? 2 : b;
  return (const float*)(P.ws + OFF_MOD) + (size_t)(layer * 3 + mi) * 6144;
}

constexpr int LDT = 72;
constexpr int LDG = 40;
typedef float f32x16 __attribute__((ext_vector_type(16)));
template <int MW, int NT>
__device__ __forceinline__ void gemm_core(const bf16_t* __restrict__ A, int lda, const bf16_t* __restrict__ Bt, int ldb, int K, f32x16 (&acc)[MW / 2][NT / 2], bf16_t* sm) {
  const int tid = otid(), lane = tid & 63, w = tid >> 6, r = lane & 31, h = lane >> 5;
  const int ldr = tid >> 3, ldk = (tid & 7) * 8;
  constexpr int NA = 2 * MW, NB = NT / 2, LDK = 72;
  u32x4 ra[NA], rb[NB];
  const bf16_t* ap = A + (size_t)ldr * lda + ldk;
  const bf16_t* bp = Bt + (size_t)ldr * ldb + ldk;
  bf16_t* As = sm; bf16_t* Bs = sm + 64 * MW * LDK;
  const int nk = K >> 6;
  auto gload = [&](int kt) {
#pragma unroll
    for (int i = 0; i < NA; ++i) ra[i] = *(const u32x4*)(ap + (size_t)(32 * i) * lda + kt * 64);
#pragma unroll
    for (int i = 0; i < NB; ++i) rb[i] = *(const u32x4*)(bp + (size_t)(32 * i) * ldb + kt * 64);
  };
  gload(0);
  for (int kt = 0; kt < nk; ++kt) {
    __syncthreads();
#pragma unroll
    for (int i = 0; i < NA; ++i) *(u32x4*)(As + (ldr + 32 * i) * LDK + ldk) = ra[i];
#pragma unroll
    for (int i = 0; i < NB; ++i) *(u32x4*)(Bs + (ldr + 32 * i) * LDK + ldk) = rb[i];
    __syncthreads();
    gload(min(kt + 1, nk - 1));
    __builtin_amdgcn_s_setprio(1);
#pragma unroll
    for (int ks = 0; ks < 4; ++ks) {
      s16x8 af[MW / 2], bfr[NT / 2];
#pragma unroll
      for (int m = 0; m < MW / 2; ++m) af[m] = *(const s16x8*)(As + (16 * MW * w + 32 * m + r) * LDK + 16 * ks + 8 * h);
#pragma unroll
      for (int n = 0; n < NT / 2; ++n) bfr[n] = *(const s16x8*)(Bs + (32 * n + r) * LDK + 16 * ks + 8 * h);
#pragma unroll
      for (int m = 0; m < MW / 2; ++m)
#pragma unroll
        for (int n = 0; n < NT / 2; ++n) acc[m][n] = __builtin_amdgcn_mfma_f32_32x32x16_bf16(af[m], bfr[n], acc[m][n], 0, 0, 0);
    }
    __builtin_amdgcn_s_setprio(0);
  }
  __syncthreads();
}

template <int MW, int NT>
__device__ __forceinline__ void zero_acc(f32x16 (&acc)[MW / 2][NT / 2]) {
#pragma unroll
  for (int m = 0; m < MW / 2; ++m)
#pragma unroll
    for (int n = 0; n < NT / 2; ++n)
#pragma unroll
      for (int e = 0; e < 16; ++e) acc[m][n][e] = 0.f;
}
__device__ __forceinline__ int big_R0(int bt) { return (bt >> 5) * PB + NCTX + (bt & 31) * 256; }
__device__ __forceinline__ int small_R0(int st) { return (st >> 1) * PB + (st & 1) * 128; }

__device__ __forceinline__ int winmap(int n) {
  if (n < 3072) return n;
  if (n < 4608) return n + 16;
  if (n < 5632) return 5648 + (n - 4608);
  if (n < 7680) { const int j = (n - 5632) >> 7, c = (n - 5632) & 127; return c < 64 ? 4624 + 64 * j + c : 6672 + 64 * j + (c - 64); }
  return 7696 + (n - 7680);
}
__device__ void convert_tile(const float* __restrict__ src, int lds, int srccol0, bf16_t* __restrict__ dst, int K, int kt, int n0, float* tl) {
  const int tid = otid();
  __syncthreads();
#pragma unroll
  for (int i = 0; i < 4; ++i) {
    const int k = i * 16 + (tid >> 4), n4 = (tid & 15) * 4;
    const f32x4 v = *(const f32x4*)(src + (size_t)(kt * 64 + k) * lds + srccol0 + n4);
    tl[k * 65 + n4] = v[0]; tl[k * 65 + n4 + 1] = v[1]; tl[k * 65 + n4 + 2] = v[2]; tl[k * 65 + n4 + 3] = v[3];
  }
  __syncthreads();
  const int n = tid >> 2, ks = (tid & 3) * 16;
  u32x4 o0, o1;
  o0.x = pk2(tl[(ks + 0) * 65 + n], tl[(ks + 1) * 65 + n]); o0.y = pk2(tl[(ks + 2) * 65 + n], tl[(ks + 3) * 65 + n]);
  o0.z = pk2(tl[(ks + 4) * 65 + n], tl[(ks + 5) * 65 + n]); o0.w = pk2(tl[(ks + 6) * 65 + n], tl[(ks + 7) * 65 + n]);
  o1.x = pk2(tl[(ks + 8) * 65 + n], tl[(ks + 9) * 65 + n]); o1.y = pk2(tl[(ks + 10) * 65 + n], tl[(ks + 11) * 65 + n]);
  o1.z = pk2(tl[(ks + 12) * 65 + n], tl[(ks + 13) * 65 + n]); o1.w = pk2(tl[(ks + 14) * 65 + n], tl[(ks + 15) * 65 + n]);
  bf16_t* d = dst + (size_t)(n0 + n) * K + kt * 64 + ks;
  *(u32x4*)d = o0; *(u32x4*)(d + 8) = o1;
}
constexpr int CONV_A_ITEMS = 2688 + 4 * 256, CONV_B_ITEMS = 2048;
__device__ void convert_item(const Params& P, int layer, int set, int item, float* tl) {
  if (set == 0) {
    if (item < 2688) { const int nt = item % 168, kt = item / 168; convert_tile(P.w_in + (size_t)layer * 1024 * INC, INC, winmap(nt * 64), wbuf(P, W_IN), 1024, kt, nt * 64, tl); return; }
    item -= 2688; const int j = item >> 8, t = item & 255, nt = t & 15, kt = t >> 4;
    const float* src = (j == 0 ? P.wpm : j == 1 ? P.wpa : j == 2 ? P.wpc : P.wout) + (size_t)layer * 1024 * 1024;
    convert_tile(src, 1024, nt * 64, wbuf(P, W_PM + (size_t)j * 2097152), 1024, kt, nt * 64, tl);
  } else {
    if (item < 1024) { const int nt = item & 63, kt = item >> 6; convert_tile(P.wup + (size_t)layer * 1024 * 4096, 4096, nt * 64, wbuf(P, W_UP), 1024, kt, nt * 64, tl); }
    else { item -= 1024; const int nt = item & 15, kt = item >> 4; convert_tile(P.wdn + (size_t)layer * 4096 * 1024, 1024, nt * 64, wbuf(P, W_DN), 4096, kt, nt * 64, tl); }
  }
}

__device__ void mod_item(const Params& P, int item, float* sv) {
  const int tid = otid(), l = item / 96, j0 = (item % 96) * 64;
  __syncthreads();
  for (int idx = tid; idx < 3072; idx += 256) { const int mi = idx >> 10, k = idx & 1023; const float v = mi < 2 ? P.c[mi * 1024 + k] : P.c_ctx[k]; sv[idx] = v / (1.f + __expf(-v)); }
  __syncthreads();
  const int kg = tid >> 6, jl = tid & 63;
  float a0 = 0.f, a1 = 0.f, a2 = 0.f;
  const float* wp = P.w_ada + ((size_t)l * 1024 + kg * 256) * 6144 + j0 + jl;
#pragma unroll 8
  for (int k = 0; k < 256; ++k) { const float wv = wp[(size_t)k * 6144]; a0 += sv[kg * 256 + k] * wv; a1 += sv[1024 + kg * 256 + k] * wv; a2 += sv[2048 + kg * 256 + k] * wv; }
  float* red = sv + 3072;
  red[(kg * 3 + 0) * 64 + jl] = a0; red[(kg * 3 + 1) * 64 + jl] = a1; red[(kg * 3 + 2) * 64 + jl] = a2;
  __syncthreads();
  if (tid < 192) { const int m = tid >> 6; float s = P.b_ada[l * 6144 + j0 + jl];
    for (int q = 0; q < 4; ++q) s += red[(q * 3 + m) * 64 + jl];
    ((float*)(P.ws + OFF_MOD))[(size_t)(l * 3 + m) * 6144 + j0 + jl] = s; }
}
__device__ void rope_item(const Params& P) {
  const int tid = otid();
  f32x2* rt = (f32x2*)(P.ws + OFF_ROPE);
  for (int e = tid; e < 4096; e += 256) {
    const int pos = e >> 5, f = e & 31;
    double inv = 1.0; for (int q = 0; q < f; ++q) inv *= 0.7498942093324559;
    const float invf = (float)inv; const float angf = (float)pos * invf;
    const double x = (double)angf;
    const double n = rint(x / 6.283185307179586), r = x - n * 6.283185307179586, r2 = r * r;
    double ts = 1.0, tc = 1.0, ss = 1.0, sc = 1.0;
    for (int k = 1; k <= 14; ++k) { tc *= -r2 / (double)((2 * k - 1) * (2 * k)); sc += tc; ts *= -r2 / (double)((2 * k) * (2 * k + 1)); ss += ts; }
    rt[e] = (f32x2){(float)sc, (float)(r * ss)};
  }
}
__device__ void phase_prologue(const Params& P, char* sm) {
  for (int i = blockIdx.x * 256 + otid(); i < 512 * 1024 / 4; i += gridDim.x * 256) ((f32x4*)(P.ws + OFF_CTXB))[i] = ((const f32x4*)P.ctx)[i];
  const int NI = CONV_A_ITEMS + CONV_B_ITEMS + 192 + 1 + 2;
  for (int it = blockIdx.x; it < NI; it += gridDim.x) {
    if (it < CONV_A_ITEMS) convert_item(P, 0, 0, it, (float*)sm);
    else if (it < CONV_A_ITEMS + CONV_B_ITEMS) convert_item(P, 0, 1, it - CONV_A_ITEMS, (float*)sm);
    else if (it < CONV_A_ITEMS + CONV_B_ITEMS + 192) mod_item(P, it - CONV_A_ITEMS - CONV_B_ITEMS, (float*)sm);
    else if (it == CONV_A_ITEMS + CONV_B_ITEMS + 192) rope_item(P);
    else {
      const int l = it - (CONV_A_ITEMS + CONV_B_ITEMS + 193);
      const float* wi = P.w_in + (size_t)l * 1024 * INC + 3072; float* gw = (float*)(P.ws + OFF_GW) + l * 16384;
      for (int idx = otid(); idx < 16384; idx += 256) { const int k = idx >> 4, j = idx & 15; gw[j * 1024 + k] = wi[(size_t)k * INC + j]; }
    }
  }
}

__device__ void phase_norm(const Params& P, int layer, int which, char* smc) {
  float* wgt = (float*)smc;
  const int tid = otid(), lane = tid & 63, w = tid >> 6;
  if (which == 0) {
    const f32x4* gw = (const f32x4*)(P.ws + OFF_GW) + layer * 4096;
#pragma unroll
    for (int i = 0; i < 16; ++i) ((f32x4*)wgt)[tid + 256 * i] = gw[tid + 256 * i];
    __syncthreads();
  }
  const float* gvec = (which == 0 ? P.norm1 : P.norm2) + layer * 1024;
  bf16_t* hout = slot(P, 0);
  auto loadrow = [&](int R, f32x4 (&xv)[4]) {
    const float* xr = (which == 0) ? xsrc_row(P, layer == 0, R) : (const float*)xdst_row(P, R);
#pragma unroll
    for (int i = 0; i < 4; ++i) xv[i] = *(const f32x4*)(xr + 256 * i + lane * 4);
  };
  const int rstride = gridDim.x * 4;
  f32x4 xn[4];
  int R = blockIdx.x * 4 + w;
  if (R < TR) loadrow(R, xn);
  for (; R < TR; R += rstride) {
    f32x4 xv[4];
#pragma unroll
    for (int i = 0; i < 4; ++i) xv[i] = xn[i];
    if (R + rstride < TR) loadrow(R + rstride, xn);
    const int b = R / PB, p = R - b * PB;
    if (layer == 1 && which == 1 && p < NCTX) continue;
    const float* mod = (const float*)(P.ws + OFF_MOD) + (size_t)(layer * 3 + (p < NCTX ? 2 : b)) * 6144 + (which == 0 ? 0 : 3072);
    f32x4 gv4[4], sh4[4], sc4[4];
#pragma unroll
    for (int i = 0; i < 4; ++i) { const int col = 256 * i + lane * 4; gv4[i] = *(const f32x4*)(gvec + col); sh4[i] = *(const f32x4*)(mod + col); sc4[i] = *(const f32x4*)(mod + 1024 + col); }
    float ss = 0.f;
#pragma unroll
    for (int i = 0; i < 4; ++i) ss += xv[i][0] * xv[i][0] + xv[i][1] * xv[i][1] + xv[i][2] * xv[i][2] + xv[i][3] * xv[i][3];
#pragma unroll
    for (int o = 32; o >= 1; o >>= 1) ss += shx(ss, o, lane);
    const float rstd = rsqrtf(ss * (1.f / 1024.f) + EPS);
#pragma unroll
    for (int i = 0; i < 4; ++i) {
#pragma unroll
      for (int e = 0; e < 4; ++e) xv[i][e] = (xv[i][e] * rstd * gv4[i][e]) * (1.f + sc4[i][e]) + sh4[i][e];
    }
#pragma unroll
    for (int i = 0; i < 4; ++i) {
      u32x2 o; o.x = pk2(xv[i][0], xv[i][1]); o.y = pk2(xv[i][2], xv[i][3]);
      *(u32x2*)(hout + (size_t)R * 1024 + 256 * i + lane * 4) = o;
    }
    if (which == 0) {
      float sj[16];
#pragma unroll
      for (int j = 0; j < 16; ++j) {
        float sacc = 0.f;
#pragma unroll
        for (int i = 0; i < 4; ++i) { const f32x4 wv = *(const f32x4*)(wgt + j * 1024 + 256 * i + lane * 4); sacc += xv[i][0] * wv[0] + xv[i][1] * wv[1] + xv[i][2] * wv[2] + xv[i][3] * wv[3]; }
        sj[j] = sacc;
      }
      const bool b5 = lane & 32, b4 = lane & 16, b3 = lane & 8, b2 = lane & 4;
      float a8[8], a4[4], a2[2];
#pragma unroll
      for (int j = 0; j < 8; ++j) { const float keep = b5 ? sj[8 + j] : sj[j], send = b5 ? sj[j] : sj[8 + j]; a8[j] = keep + shx(send, 32, lane); }
#pragma unroll
      for (int j = 0; j < 4; ++j) { const float keep = b4 ? a8[4 + j] : a8[j], send = b4 ? a8[j] : a8[4 + j]; a4[j] = keep + shx(send, 16, lane); }
#pragma unroll
      for (int j = 0; j < 2; ++j) { const float keep = b3 ? a4[2 + j] : a4[j], send = b3 ? a4[j] : a4[2 + j]; a2[j] = keep + shx(send, 8, lane); }
      float e = (b2 ? a2[1] : a2[0]) + shx(b2 ? a2[0] : a2[1], 4, lane);
      e += shx(e, 1, lane); e += shx(e, 2, lane);
      if ((lane & 3) == 0) ((float*)(P.ws + OFF_GATES))[(size_t)R * 16 + (lane >> 2)] = e + P.gate_b[layer * 16 + (lane >> 2)];
    }
  }
  if (which == 1 && layer == 0) { for (int it = blockIdx.x; it < CONV_A_ITEMS; it += gridDim.x) convert_item(P, 1, 0, it, (float*)smc); }
  if (which == 0 && layer == 1) { for (int it = blockIdx.x; it < CONV_B_ITEMS; it += gridDim.x) convert_item(P, 1, 1, it, (float*)smc); }
}

__device__ __forceinline__ bool gemm_unit(int i, int NTN, bool withCtx, bool& isBig, int& R0, int& nt) {
  const int x = blockIdx.x & 7, loc = blockIdx.x >> 3, nloc = gridDim.x >> 3;
  int j = loc + i * nloc;
  if (j < 8 * NTN) {
    const int jl = j & 63;
    isBig = true; nt = (j >> 6) * 8 + ((jl & 1) | ((jl >> 4) << 1)); R0 = big_R0(8 * x + ((jl >> 1) & 7)); return true;
  }
  j -= 8 * NTN;
  if (!withCtx) return false;
  const int sidx = x + 8 * j;
  if (sidx >= 4 * NTN) return false;
  isBig = false; nt = sidx % NTN; R0 = small_R0(sidx / NTN); return true;
}

template <int NT>
__device__ __forceinline__ void flush_pass(const bf16_t* smw, bf16_t* dst, int ld, int lane) {
  constexpr int LDW = 16 * NT + 8, CPR = 2 * NT;
#pragma unroll
  for (int j = 0; j < NT; ++j) {
    const int c = lane + 64 * j, row = c / CPR, cc = c % CPR;
    const u32x4 v = *(const u32x4*)(smw + row * LDW + cc * 8);
    *(u32x4*)(dst + (size_t)row * ld + cc * 8) = v;
  }
}
template <int MW, int LD>
__device__ __forceinline__ void store_nat(const f32x16 (&acc)[MW / 2][4], bf16_t* base, float scale, bf16_t* sm, int w, int lane) {
  const int r = lane & 31, h = lane >> 5;
  bf16_t* smw = sm + w * 32 * 136;
#pragma unroll
  for (int m = 0; m < MW / 2; ++m) {
#pragma unroll
    for (int q = 0; q < 4; ++q)
#pragma unroll
      for (int i = 0; i < 4; ++i)
#pragma unroll
        for (int n = 0; n < 4; ++n) smw[(8 * q + 4 * h + i) * 136 + 32 * n + r] = f2bf(acc[m][n][4 * q + i] * scale);
    flush_pass<8>(smw, base + (size_t)(16 * MW * w + 32 * m) * LD, LD, lane);
  }
}
template <int MW>
__device__ __forceinline__ void store_tr(const f32x16 (&acc)[MW / 2][4], bf16_t* base, int w, int lane) {
  const int r = lane & 31, h = lane >> 5;
  bf16_t* p = base + (size_t)r * PB + 16 * MW * w + 4 * h;
#pragma unroll
  for (int m = 0; m < MW / 2; ++m)
#pragma unroll
    for (int n = 0; n < 4; ++n)
#pragma unroll
      for (int q = 0; q < 4; ++q) { u32x2 o; o.x = pk2(acc[m][n][4 * q], acc[m][n][4 * q + 1]); o.y = pk2(acc[m][n][4 * q + 2], acc[m][n][4 * q + 3]); *(u32x2*)(p + (size_t)(32 * n) * PB + 32 * m + 8 * q) = o; }
}
template <int MW>
__device__ __forceinline__ void inproj_tile(const Params& P, int layer, int R0, int nt_, bf16_t* sm) {
  const int tid = otid(), lane = tid & 63, w = tid >> 6, r = lane & 31, h = lane >> 5;
  const bf16_t* h1 = slot(P, 0);
  const bf16_t* WinT = wbuf(P, W_IN);
  bf16_t* cu = slot(P, 1); bf16_t* cB = slot(P, 2);
  bf16_t* mq = slot(P, 3); bf16_t* mk = mq + (size_t)TR * 512;
  bf16_t* mkT = slot(P, 4); bf16_t* ak = mkT + (size_t)TR * 512; bf16_t* avT = ak + (size_t)TR * 256;
  bf16_t* mvT = slot(P, 5); bf16_t* mo = slot(P, 6); bf16_t* aq = slot(P, 7);
  const f32x2* rope = (const f32x2*)(P.ws + OFF_ROPE);
  f32x16 acc[MW / 2][4]; zero_acc<MW, 8>(acc);
  gemm_core<MW, 8>(h1 + (size_t)R0 * 1024, 1024, WinT + (size_t)nt_ * 128 * 1024, 1024, 1024, acc, sm);
  const int b = R0 / PB, p0 = R0 - b * PB, rw = 16 * MW * w;
  if (nt_ < 4) store_nat<MW, 512>(acc, mq + (size_t)R0 * 512 + nt_ * 128, MQSCALE, sm, w, lane);
  else if (nt_ < 8) { store_nat<MW, 512>(acc, mk + (size_t)R0 * 512 + (nt_ - 4) * 128, 1.f, sm, w, lane); store_tr<MW>(acc, mkT + (size_t)(b * 512 + (nt_ - 4) * 128) * PB + p0, w, lane); }
  else if (nt_ < 16) store_tr<MW>(acc, mvT + (size_t)(b * 1024 + (nt_ - 8) * 128) * PB + p0, w, lane);
  else if (nt_ < 24) store_nat<MW, 1024>(acc, mo + (size_t)R0 * 1024 + (nt_ - 16) * 128, 1.f, sm, w, lane);
  else if (nt_ < 34) {
    const bool isq = nt_ < 32;
    const float* gn = (isq ? P.qn : P.kn) + layer * 128;
    float gv[4];
#pragma unroll
    for (int n = 0; n < 4; ++n) gv[n] = gn[32 * n + r];
    const float scale = isq ? QSCALE : 1.f;
    bf16_t* smw = sm + w * 32 * 136;
#pragma unroll
    for (int m = 0; m < MW / 2; ++m) {
#pragma unroll
      for (int q = 0; q < 4; ++q)
#pragma unroll
        for (int i = 0; i < 4; ++i) {
          float v[4]; float ss = 0.f;
#pragma unroll
          for (int n = 0; n < 4; ++n) { v[n] = acc[m][n][4 * q + i]; ss += v[n] * v[n]; }
          ss += shx(ss, 1, lane); ss += shx(ss, 2, lane); ss += shx(ss, 4, lane); ss += shx(ss, 8, lane); ss += shx(ss, 16, lane);
          const float rstd = rsqrtf(ss * (1.f / 128.f) + EPS);
#pragma unroll
          for (int n = 0; n < 4; ++n) v[n] = v[n] * rstd * gv[n];
          if (p0 >= NCTX) {
            const int sidx = p0 - NCTX + rw + 32 * m + 8 * q + 4 * h + i, ri = sidx >> 6, ci = sidx & 63;
            const f32x2 a = rope[ri * 32 + r]; const float x1 = v[0], x2 = v[1];
            v[0] = x1 * a.x - x2 * a.y; v[1] = x1 * a.y + x2 * a.x;
            const f32x2 c2 = rope[ci * 32 + r]; const float y1 = v[2], y2 = v[3];
            v[2] = y1 * c2.x - y2 * c2.y; v[3] = y1 * c2.y + y2 * c2.x;
          }
#pragma unroll
          for (int n = 0; n < 4; ++n) smw[(8 * q + 4 * h + i) * 136 + 32 * n + r] = f2bf(v[n] * scale);
        }
      if (isq) flush_pass<8>(smw, aq + (size_t)(R0 + rw + 32 * m) * 1024 + (nt_ - 24) * 128, 1024, lane);
      else flush_pass<8>(smw, ak + (size_t)(R0 + rw + 32 * m) * 256 + (nt_ - 32) * 128, 256, lane);
    }
  }
  else if (nt_ < 36) store_tr<MW>(acc, avT + (size_t)(b * 256 + (nt_ - 34) * 128) * PB + p0, w, lane);
  else if (nt_ < 44) store_nat<MW, 1024>(acc, cB + (size_t)R0 * 1024 + (nt_ - 36) * 128, 1.f, sm, w, lane);
  else {
    bf16_t* smw = sm + w * 32 * 72;
#pragma unroll
    for (int m = 0; m < MW / 2; ++m) {
#pragma unroll
      for (int q = 0; q < 4; ++q)
#pragma unroll
        for (int i = 0; i < 4; ++i)
#pragma unroll
          for (int n = 0; n < 2; ++n) smw[(8 * q + 4 * h + i) * 72 + 32 * n + r] = f2bf(acc[m][n][4 * q + i] * acc[m][n + 2][4 * q + i]);
      flush_pass<4>(smw, cu + (size_t)(R0 + rw + 32 * m) * 1024 + 64 * (nt_ - 44), 1024, lane);
    }
  }
}
__device__ void phase_inproj(const Params& P, int layer, char* smc) {
  bf16_t* sm = (bf16_t*)smc;
  for (int i = 0;; ++i) {
    bool big; int R0, nt;
    if (!gemm_unit(i, 60, true, big, R0, nt)) break;
    if (big) inproj_tile<4>(P, layer, R0, nt, sm); else inproj_tile<2>(P, layer, R0, nt, sm);
  }
}

__device__ void phase_conv(const Params& P, int layer) {
  const bf16_t* cu = slot(P, 1); bf16_t* cB = slot(P, 2);
  const float* cw = P.conv_w + (size_t)layer * 3 * 1024;
  const int tid = otid();
  const int stride = gridDim.x * 256;
  int idx = blockIdx.x * 256 + tid;
  const int ch = (idx & 127) * 8;
  float w0[8], w1[8], w2[8];
#pragma unroll
  for (int e = 0; e < 8; ++e) { w0[e] = cw[ch + e]; w1[e] = cw[1024 + ch + e]; w2[e] = cw[2048 + ch + e]; }
  const u32x4 z = {0u, 0u, 0u, 0u};
  auto loaditem = [&](int id, u32x4& c0, u32x4& c1, u32x4& c2, u32x4& bg) {
    const int R = id >> 7, p = R % PB;
    const bool hasL = !(p == 0 || p == NCTX), hasR = !(p == NCTX - 1 || p == PB - 1);
    c1 = *(const u32x4*)(cu + (size_t)R * 1024 + ch);
    c0 = hasL ? *(const u32x4*)(cu + (size_t)(R - 1) * 1024 + ch) : z;
    c2 = hasR ? *(const u32x4*)(cu + (size_t)(R + 1) * 1024 + ch) : z;
    bg = *(const u32x4*)(cB + (size_t)R * 1024 + ch);
  };
  u32x4 n0 = z, n1 = z, n2 = z, nb = z;
  if (idx < TR * 128) loaditem(idx, n0, n1, n2, nb);
  for (; idx < TR * 128; idx += stride) {
    const u32x4 c0 = n0, c1 = n1, c2 = n2, bg = nb;
    if (idx + stride < TR * 128) loaditem(idx + stride, n0, n1, n2, nb);
    u32x4 o;
#pragma unroll
    for (int q = 0; q < 4; ++q) {
      const float lo = bflo(bg[q]) * (w0[2 * q] * bflo(c0[q]) + w1[2 * q] * bflo(c1[q]) + w2[2 * q] * bflo(c2[q]));
      const float hi = bfhi(bg[q]) * (w0[2 * q + 1] * bfhi(c0[q]) + w1[2 * q + 1] * bfhi(c1[q]) + w2[2 * q + 1] * bfhi(c2[q]));
      o[q] = pk2(lo, hi);
    }
    *(u32x4*)(cB + (size_t)(idx >> 7) * 1024 + ch) = o;
  }
}

constexpr int ML_QS = 0, ML_KS = 8704, ML_KW = 17408, ML_VT = 26624, ML_CT = 30080, ML_VEC_B = 73216;
__device__ void mlstm_run(const Params& P, int layer, int wg, char* smc) {
  bf16_t* sm = (bf16_t*)smc;
  bf16_t* Qs = sm + ML_QS; bf16_t* Ks = sm + ML_KS; bf16_t* KWt = sm + ML_KW; bf16_t* Vt = sm + ML_VT; bf16_t* Ct = sm + ML_CT; bf16_t* Ps = Ks;
  float* Arow = (float*)(smc + ML_VEC_B); float* Bcol = Arow + 64; float* avec = Bcol + 64; float* wkv = avec + 64; float* eFs = wkv + 64;
  const int tid = otid(), lane = tid & 63, w = tid >> 6, lr = lane & 15, g = lane >> 4;
  const int slice = wg & 7, dir = (wg >> 3) & 1, h = (wg >> 4) & 3, b = wg >> 6, v0 = slice * 32;
  const bf16_t* mq = slot(P, 3); const bf16_t* mk = mq + (size_t)TR * 512; const bf16_t* mkT = slot(P, 4); const bf16_t* mvT = slot(P, 5);
  const float* G = (const float*)(P.ws + OFF_GATES);
  bf16_t* hdir = dir == 0 ? slot(P, 1) : (layer == 0 ? (bf16_t*)P.out : slot(P, 0));
  __syncthreads();
  for (int idx = tid; idx < 16 * LDT; idx += 256) Vt[32 * LDT + idx] = (idx < LDT) ? (bf16_t)0x3F80 : (bf16_t)0;
  f32x4 Cacc[2][3];
#pragma unroll
  for (int a = 0; a < 2; ++a)
#pragma unroll
    for (int n = 0; n < 3; ++n) Cacc[a][n] = (f32x4){0.f, 0.f, 0.f, 0.f};
  u32x4 rq[4], rk[4], rkt[4], rvt; float gi = 0.f, gf = 0.f;
  const int qs_r = tid >> 4, qs_c = (tid & 15) * 8;
  const int kt_d = tid >> 3, kt_s = (tid & 7) * 8;
  auto chunk_p0 = [&](int n) { const int c = (dir == 0) ? n : (n < 4 ? 3 - n : 135 - n); return c * 64; };
  auto prefetch = [&](int n) {
    const int p0 = chunk_p0(n); const size_t R0 = (size_t)b * PB + p0;
#pragma unroll
    for (int i = 0; i < 4; ++i) {
      rq[i] = *(const u32x4*)(mq + (R0 + qs_r + 16 * i) * 512 + h * 128 + qs_c);
      rk[i] = *(const u32x4*)(mk + (R0 + qs_r + 16 * i) * 512 + h * 128 + qs_c);
      rkt[i] = *(const u32x4*)(mkT + (size_t)(b * 512 + h * 128 + kt_d + 32 * i) * PB + p0 + kt_s);
    }
    rvt = *(const u32x4*)(mvT + (size_t)(b * 1024 + h * 256 + v0 + kt_d) * PB + p0 + kt_s);
    if (tid < 64) { gi = G[(R0 + tid) * 16 + dir * 8 + h]; gf = G[(R0 + tid) * 16 + dir * 8 + 4 + h]; }
  };
  prefetch(0);
  for (int n = 0; n < 132; ++n) {
    const int p0 = chunk_p0(n); const size_t R0 = (size_t)b * PB + p0;
    __syncthreads();
#pragma unroll
    for (int i = 0; i < 4; ++i) { *(u32x4*)(Qs + (qs_r + 16 * i) * 136 + qs_c) = rq[i]; *(u32x4*)(Ks + (qs_r + 16 * i) * 136 + qs_c) = rk[i]; }
    *(u32x4*)(Vt + kt_d * LDT + kt_s) = rvt;
#pragma unroll
    for (int a = 0; a < 2; ++a)
#pragma unroll
      for (int nv = 0; nv < 3; ++nv) { u32x2 o; o.x = pk2(Cacc[a][nv][0], Cacc[a][nv][1]); o.y = pk2(Cacc[a][nv][2], Cacc[a][nv][3]);
        *(u32x2*)(Ct + (16 * nv + lr) * 136 + 16 * (2 * w + a) + 4 * g) = o; }
    if (w == 0) {
      const float lf = fminf(gf, 0.f) - __logf(1.f + __expf(-fabsf(gf)));
      float bc = lf;
#pragma unroll
      for (int off = 1; off < 64; off <<= 1) {
        const float o = shl_(bc, ((dir == 0) ? lane - off : lane + off) & 63);
        const bool ok = (dir == 0) ? (lane >= off) : (lane + off < 64);
        if (ok) bc += o;
      }
      const float Ftot = shl_(bc, dir == 0 ? 63 : 0);
      Arow[lane] = bc; Bcol[lane] = gi - bc; avec[lane] = __expf(bc); wkv[lane] = __expf(Ftot - bc + gi);
      if (lane == 0) eFs[0] = __expf(Ftot);
    }
    __syncthreads();
    {
      const f32x4 wa = *(const f32x4*)(wkv + kt_s), wb = *(const f32x4*)(wkv + kt_s + 4);
#pragma unroll
      for (int i = 0; i < 4; ++i) {
        u32x4 o;
        o.x = pk2(bflo(rkt[i].x) * wa[0], bfhi(rkt[i].x) * wa[1]); o.y = pk2(bflo(rkt[i].y) * wa[2], bfhi(rkt[i].y) * wa[3]);
        o.z = pk2(bflo(rkt[i].z) * wb[0], bfhi(rkt[i].z) * wb[1]); o.w = pk2(bflo(rkt[i].w) * wb[2], bfhi(rkt[i].w) * wb[3]);
        *(u32x4*)(KWt + (kt_d + 32 * i) * LDT + kt_s) = o;
      }
    }
    s16x8 qf[4];
#pragma unroll
    for (int ks = 0; ks < 4; ++ks) qf[ks] = *(const s16x8*)(Qs + (16 * w + lr) * 136 + 32 * ks + 8 * g);
    f32x4 sT[4];
#pragma unroll
    for (int st = 0; st < 4; ++st) {
      sT[st] = (f32x4){0.f, 0.f, 0.f, 0.f};
#pragma unroll
      for (int ks = 0; ks < 4; ++ks) { const s16x8 kf = *(const s16x8*)(Ks + (16 * st + lr) * 136 + 32 * ks + 8 * g); sT[st] = __builtin_amdgcn_mfma_f32_16x16x32_bf16(kf, qf[ks], sT[st], 0, 0, 0); }
    }
    {
      const int t = 16 * w + lr; const float ar = Arow[t];
#pragma unroll
      for (int st = 0; st < 4; ++st) {
        const f32x4 bc4 = *(const f32x4*)(Bcol + 16 * st + 4 * g);
#pragma unroll
        for (int i = 0; i < 4; ++i) {
          const int s = 16 * st + 4 * g + i;
          const bool ok = (dir == 0) ? (s <= t) : (s >= t);
          sT[st][i] = ok ? sT[st][i] * __expf(ar + bc4[i]) : 0.f;
        }
      }
    }
    __syncthreads();
    if (n + 1 < 132) prefetch(n + 1);
    s16x8 vf[3][2];
#pragma unroll
    for (int nv = 0; nv < 3; ++nv)
#pragma unroll
      for (int sg = 0; sg < 2; ++sg) {
        const u32x2 lo = *(const u32x2*)(Vt + (16 * nv + lr) * LDT + 32 * sg + 4 * g), hi = *(const u32x2*)(Vt + (16 * nv + lr) * LDT + 32 * sg + 16 + 4 * g);
        u32x4 vv; vv.x = lo.x; vv.y = lo.y; vv.z = hi.x; vv.w = hi.y; vf[nv][sg] = __builtin_bit_cast(s16x8, vv);
      }
    f32x4 hI[3], hC[3];
#pragma unroll
    for (int nv = 0; nv < 3; ++nv) { hI[nv] = (f32x4){0.f, 0.f, 0.f, 0.f}; hC[nv] = (f32x4){0.f, 0.f, 0.f, 0.f}; }
#pragma unroll
    for (int sg = 0; sg < 2; ++sg) {
      u32x4 pk; pk.x = pk2(sT[2 * sg][0], sT[2 * sg][1]); pk.y = pk2(sT[2 * sg][2], sT[2 * sg][3]); pk.z = pk2(sT[2 * sg + 1][0], sT[2 * sg + 1][1]); pk.w = pk2(sT[2 * sg + 1][2], sT[2 * sg + 1][3]);
      const s16x8 pf = __builtin_bit_cast(s16x8, pk);
#pragma unroll
      for (int nv = 0; nv < 3; ++nv) hI[nv] = __builtin_amdgcn_mfma_f32_16x16x32_bf16(pf, vf[nv][sg], hI[nv], 0, 0, 0);
    }
#pragma unroll
    for (int ks = 0; ks < 4; ++ks)
#pragma unroll
      for (int nv = 0; nv < 3; ++nv) { const s16x8 cf = *(const s16x8*)(Ct + (16 * nv + lr) * 136 + 32 * ks + 8 * g); hC[nv] = __builtin_amdgcn_mfma_f32_16x16x32_bf16(qf[ks], cf, hC[nv], 0, 0, 0); }
    {
      const f32x4 av4 = *(const f32x4*)(avec + 16 * w + 4 * g);
#pragma unroll
      for (int i = 0; i < 4; ++i) {
        const float den = hI[2][i] + av4[i] * hC[2][i];
        const float dn = shl_(den, lane & 48);
        const float inv = 1.f / fmaxf(fabsf(dn), 1.f);
#pragma unroll
        for (int nv = 0; nv < 2; ++nv) hdir[(R0 + 16 * w + 4 * g + i) * 1024 + h * 256 + v0 + 16 * nv + lr] = f2bf((hI[nv][i] + av4[i] * hC[nv][i]) * inv);
      }
    }
    {
      const float ef = eFs[0];
#pragma unroll
      for (int a = 0; a < 2; ++a) {
#pragma unroll
        for (int nv = 0; nv < 3; ++nv) Cacc[a][nv] = Cacc[a][nv] * ef;
#pragma unroll
        for (int sg = 0; sg < 2; ++sg) {
          const u32x2 klo = *(const u32x2*)(KWt + (16 * (2 * w + a) + lr) * LDT + 32 * sg + 4 * g), khi = *(const u32x2*)(KWt + (16 * (2 * w + a) + lr) * LDT + 32 * sg + 16 + 4 * g);
          u32x4 kk; kk.x = klo.x; kk.y = klo.y; kk.z = khi.x; kk.w = khi.y; const s16x8 kw = __builtin_bit_cast(s16x8, kk);
#pragma unroll
          for (int nv = 0; nv < 3; ++nv) Cacc[a][nv] = __builtin_amdgcn_mfma_f32_16x16x32_bf16(kw, vf[nv][sg], Cacc[a][nv], 0, 0, 0);
        }
      }
    }
  }
}

#define YA_DST(P, l) slot(P, 7)
__device__ void attn_unit(const Params& P, int layer_, int u, int half, char* smc) {
  constexpr int LDV = 68;
  bf16_t* Ksm = (bf16_t*)smc;
  bf16_t* Vsm = Ksm + 64 * 136;
  const int tid = otid(), lane = tid & 63, w = tid >> 6, r = lane & 31, h = lane >> 5;
  int b, head, pq0, nkeys;
  if (u < 1024) { b = u >> 9; head = (u >> 6) & 7; pq0 = NCTX + 128 * (u & 63); nkeys = PB; }
  else { const int v = u - 1024; b = v >> 4; head = (v >> 1) & 7; pq0 = 128 * (v & 1); nkeys = NCTX; }
  const int kvh = head >> 2;
  const int kbeg = half > 0 ? half * (PB / 4) : 0, kend = half >= 0 ? (half + 1) * (PB / 4) : nkeys;
  bf16_t* aq = slot(P, 7);
  const bf16_t* ak = slot(P, 4) + (size_t)TR * 512; const bf16_t* avT = ak + (size_t)TR * 256;
  constexpr int ABUF = 64 * 136 + 128 * LDV;
  s16x8 qf[8];
#pragma unroll
  for (int ks = 0; ks < 8; ++ks) qf[ks] = *(const s16x8*)(aq + (size_t)(b * PB + pq0 + 32 * w + r) * 1024 + head * 128 + 16 * ks + 8 * h);
  f32x16 O[4];
#pragma unroll
  for (int d = 0; d < 4; ++d)
#pragma unroll
    for (int e = 0; e < 16; ++e) O[d][e] = 0.f;
  float mrun = 0.f, lrun = 0.f;
  f32x16 cinit;
#pragma unroll
  for (int e = 0; e < 16; ++e) cinit[e] = 0.f;
  const int k_r = tid >> 4, k_c = (tid & 15) * 8, v_d = tid >> 3, v_c = (tid & 7) * 8;
  const bf16_t* kp = ak + (size_t)(b * PB + kbeg + k_r) * 256 + kvh * 128 + k_c;
  const bf16_t* vp = avT + (size_t)(b * 256 + kvh * 128 + v_d) * PB + kbeg + v_c;
  const int nkt = kend - kbeg;
  u32x4 rk[4], rv[4];
  auto stage = [&](bf16_t* Kd, bf16_t* Vd) {
#pragma unroll
    for (int i = 0; i < 4; ++i) {
      *(u32x4*)(Kd + (k_r + 16 * i) * 136 + k_c) = rk[i];
      u32x2 lo, hi; lo.x = rv[i].x; lo.y = rv[i].y; hi.x = rv[i].z; hi.y = rv[i].w;
      *(u32x2*)(Vd + (v_d + 32 * i) * LDV + v_c) = lo; *(u32x2*)(Vd + (v_d + 32 * i) * LDV + v_c + 4) = hi;
    }
  };
#pragma unroll
  for (int i = 0; i < 4; ++i) { rk[i] = *(const u32x4*)(kp + (size_t)(16 * i) * 256); rv[i] = *(const u32x4*)(vp + (size_t)(32 * i) * PB); }
  __syncthreads();
  stage(Ksm, Vsm);
  if (64 < nkt) {
#pragma unroll
    for (int i = 0; i < 4; ++i) { rk[i] = *(const u32x4*)(kp + (size_t)(64 + 16 * i) * 256); rv[i] = *(const u32x4*)(vp + (size_t)(32 * i) * PB + 64); }
  }
  __syncthreads();
  for (int k0 = 0; k0 < nkt; k0 += 64) {
    const int cb = (k0 >> 6) & 1;
    const bf16_t* Kc = Ksm + cb * ABUF; const bf16_t* Vc = Vsm + cb * ABUF;
    if (k0 + 64 < nkt) {
      stage(Ksm + (cb ^ 1) * ABUF, Vsm + (cb ^ 1) * ABUF);
      if (k0 + 128 < nkt) {
#pragma unroll
        for (int i = 0; i < 4; ++i) { rk[i] = *(const u32x4*)(kp + (size_t)(k0 + 128 + 16 * i) * 256); rv[i] = *(const u32x4*)(vp + (size_t)(32 * i) * PB + k0 + 128); }
      }
    }
    f32x16 S[2];
#pragma unroll
    for (int ks = 0; ks < 8; ++ks)
#pragma unroll
      for (int m = 0; m < 2; ++m) {
        const s16x8 kf = *(const s16x8*)(Kc + (32 * m + r) * 136 + 16 * ks + 8 * h);
        S[m] = __builtin_amdgcn_mfma_f32_32x32x16_bf16(kf, qf[ks], ks == 0 ? cinit : S[m], 0, 0, 0);
      }
    __builtin_amdgcn_sched_barrier(0);
    float mx = -1e30f;
#pragma unroll
    for (int m = 0; m < 2; ++m)
#pragma unroll
      for (int e = 0; e < 16; ++e) mx = fmaxf(mx, S[m][e]);
    mx = fmaxf(mx, shx(mx, 32, lane));
    if (__builtin_amdgcn_ballot_w64(mx > 8.f) != 0ull) {
      const float dlt = fmaxf(mx, 0.f), alpha = __builtin_amdgcn_exp2f(-dlt);
      mrun += dlt; lrun *= alpha;
#pragma unroll
      for (int d = 0; d < 4; ++d) O[d] = O[d] * alpha;
#pragma unroll
      for (int m = 0; m < 2; ++m)
#pragma unroll
        for (int e = 0; e < 16; ++e) S[m][e] -= dlt;
#pragma unroll
      for (int e = 0; e < 16; ++e) cinit[e] = -mrun;
    }
    float ls = 0.f;
#pragma unroll
    for (int m = 0; m < 2; ++m)
#pragma unroll
      for (int e = 0; e < 16; ++e) { const float pv = __builtin_amdgcn_exp2f(S[m][e]); S[m][e] = pv; ls += pv; }
    lrun += ls;
    s16x8 pf[2][2];
#pragma unroll
    for (int m = 0; m < 2; ++m)
#pragma unroll
      for (int sg = 0; sg < 2; ++sg) {
        u32x4 pk; pk.x = pk2(S[m][8 * sg + 0], S[m][8 * sg + 1]); pk.y = pk2(S[m][8 * sg + 2], S[m][8 * sg + 3]);
        pk.z = pk2(S[m][8 * sg + 4], S[m][8 * sg + 5]); pk.w = pk2(S[m][8 * sg + 6], S[m][8 * sg + 7]);
        pf[m][sg] = __builtin_bit_cast(s16x8, pk);
      }
    __builtin_amdgcn_sched_barrier(0);
#pragma unroll
    for (int m = 0; m < 2; ++m)
#pragma unroll
      for (int sg = 0; sg < 2; ++sg)
#pragma unroll
        for (int d = 0; d < 4; ++d) {
          const u32x2 lo = *(const u32x2*)(Vc + (32 * d + r) * LDV + 32 * m + 16 * sg + 4 * h);
          const u32x2 hi = *(const u32x2*)(Vc + (32 * d + r) * LDV + 32 * m + 16 * sg + 8 + 4 * h);
          u32x4 vv; vv.x = lo.x; vv.y = lo.y; vv.z = hi.x; vv.w = hi.y;
          O[d] = __builtin_amdgcn_mfma_f32_32x32x16_bf16(__builtin_bit_cast(s16x8, vv), pf[m][sg], O[d], 0, 0, 0);
        }
    __syncthreads();
  }
  {
    float l = lrun; l += shx(l, 32, lane);
    const float inv = 1.f / l;
    const int rrow = 32 * w + r;
    bf16_t* op = YA_DST(P, layer_) + (size_t)(b * PB + pq0 + rrow) * 1024 + head * 128 + 4 * h;
    if (half >= 0) {
      const int su = u - 896;
      op = (bf16_t*)(P.ws + OFF_PO) + ((size_t)(half * 128 + su) * 128 + rrow) * 128 + 4 * h;
      if (h == 0) ((f32x2*)(P.ws + OFF_ML))[(size_t)(half * 128 + su) * 128 + rrow] = (f32x2){mrun, l};
    }
#pragma unroll
    for (int d = 0; d < 4; ++d)
#pragma unroll
      for (int q = 0; q < 4; ++q) { u32x2 o; o.x = pk2(O[d][4 * q] * inv, O[d][4 * q + 1] * inv); o.y = pk2(O[d][4 * q + 2] * inv, O[d][4 * q + 3] * inv); *(u32x2*)(op + 32 * d + 8 * q) = o; }
  }
}

__device__ void phase_mix(const Params& P, int layer, char* smc) {
  for (int wg = blockIdx.x; wg < 128; wg += gridDim.x) mlstm_run(P, layer, wg, smc);
  unsigned* cnt = (unsigned*)(P.ws + OFF_CNT) + layer;
  int* ubox = (int*)(smc + 74496);
  const int NUX = 896 + 512 + ((layer == 0) ? 32 : 0);
  for (;;) {
    __syncthreads();
    if (otid() == 0) ubox[0] = (int)atomicAdd(cnt, 1u);
    __syncthreads();
    const int it = ubox[0];
    if (it >= NUX) break;
    if (it < 896) attn_unit(P, layer, it, -1, smc);
    else if (it < 1408) attn_unit(P, layer, 896 + ((it - 896) >> 2), (it - 896) & 3, smc);
    else attn_unit(P, layer, 1024 + (it - 1408), -1, smc);
  }
}

__device__ void phase_fin(const Params& P, int layer) {
  const int tid = otid(), lane = tid & 63, w = tid >> 6;
  bf16_t* hf = slot(P, 1); const bf16_t* hb = layer == 0 ? (const bf16_t*)P.out : slot(P, 0); const bf16_t* mo = slot(P, 6); bf16_t* h1n = slot(P, 3);
  const bool redo_h1 = layer != 0;
  const float* gain = P.mnorm + layer * 1024; const float* gvec = P.norm1 + layer * 1024;
  for (int R = blockIdx.x * 4 + w; R < TR; R += gridDim.x * 4) {
    const int b = R / PB, p = R - b * PB;
    if (layer == 1 && p < NCTX) continue;
    const int col = lane * 16;
    u32x4 ha[2], hc[2], og[2]; f32x4 gn[4];
#pragma unroll
    for (int q = 0; q < 2; ++q) { ha[q] = *(const u32x4*)(hf + (size_t)R * 1024 + col + 8 * q); hc[q] = *(const u32x4*)(hb + (size_t)R * 1024 + col + 8 * q); og[q] = *(const u32x4*)(mo + (size_t)R * 1024 + col + 8 * q); }
#pragma unroll
    for (int q = 0; q < 4; ++q) gn[q] = *(const f32x4*)(gain + col + 4 * q);
    const float* xr = xsrc_row(P, layer == 0, R);
    const float* mod = (const float*)(P.ws + OFF_MOD) + (size_t)(layer * 3 + (p < NCTX ? 2 : b)) * 6144;
    f32x4 xv[4], gv4[4], sh4[4], sc4[4];
    if (redo_h1) {
#pragma unroll
      for (int i = 0; i < 4; ++i) { const int c4 = 256 * i + lane * 4; xv[i] = *(const f32x4*)(xr + c4); gv4[i] = *(const f32x4*)(gvec + c4); sh4[i] = *(const f32x4*)(mod + c4); sc4[i] = *(const f32x4*)(mod + 1024 + c4); }
    }
    const bool split = (b == 1 && p >= NCTX && lane < 32);
    f32x2 ml[4]; u32x4 pa[4];
    if (split) {
      const int sl = p - NCTX, qb = sl >> 7, r = sl & 127, hd = lane >> 4, su = hd * 64 + qb;
      const f32x2* mlp = (const f32x2*)(P.ws + OFF_ML); const bf16_t* po = (const bf16_t*)(P.ws + OFF_PO);
#pragma unroll
      for (int q = 0; q < 4; ++q) { ml[q] = mlp[(size_t)(q * 128 + su) * 128 + r]; pa[q] = *(const u32x4*)(po + ((size_t)(q * 128 + su) * 128 + r) * 128 + (lane & 15) * 8); }
    }
    float v[16]; float ss = 0.f;
#pragma unroll
    for (int q = 0; q < 2; ++q)
#pragma unroll
      for (int e = 0; e < 4; ++e) { v[8 * q + 2 * e] = bflo(ha[q][e]) + bflo(hc[q][e]); v[8 * q + 2 * e + 1] = bfhi(ha[q][e]) + bfhi(hc[q][e]); }
#pragma unroll
    for (int e = 0; e < 16; ++e) ss += v[e] * v[e];
    ss += shx(ss, 1, lane); ss += shx(ss, 2, lane); ss += shx(ss, 4, lane); ss += shx(ss, 8, lane);
    const float rstd = rsqrtf(ss * (1.f / 256.f) + EPS);
    u32x4 ym[2];
#pragma unroll
    for (int q = 0; q < 2; ++q)
#pragma unroll
      for (int e = 0; e < 4; ++e) {
        const float lo = v[8 * q + 2 * e] * rstd * gn[2 * q + (e >> 1)][(2 * e) & 3] * sigmoidf_(bflo(og[q][e]));
        const float hi = v[8 * q + 2 * e + 1] * rstd * gn[2 * q + (e >> 1)][(2 * e + 1) & 3] * sigmoidf_(bfhi(og[q][e]));
        ym[q][e] = pk2(lo, hi);
      }
    u32x2 hq[4];
    if (redo_h1) {
    float s2 = 0.f;
#pragma unroll
    for (int i = 0; i < 4; ++i) s2 += xv[i][0] * xv[i][0] + xv[i][1] * xv[i][1] + xv[i][2] * xv[i][2] + xv[i][3] * xv[i][3];
#pragma unroll
    for (int o = 32; o >= 1; o >>= 1) s2 += shx(s2, o, lane);
    const float rstd2 = rsqrtf(s2 * (1.f / 1024.f) + EPS);
#pragma unroll
    for (int i = 0; i < 4; ++i) {
#pragma unroll
      for (int e = 0; e < 4; ++e) xv[i][e] = (xv[i][e] * rstd2 * gv4[i][e]) * (1.f + sc4[i][e]) + sh4[i][e];
      hq[i].x = pk2(xv[i][0], xv[i][1]); hq[i].y = pk2(xv[i][2], xv[i][3]);
    }
    }
#pragma unroll
    for (int q = 0; q < 2; ++q) *(u32x4*)(hf + (size_t)R * 1024 + col + 8 * q) = ym[q];
#pragma unroll
    for (int i = 0; i < 4; ++i) if (redo_h1) *(u32x2*)(h1n + (size_t)R * 1024 + 256 * i + lane * 4) = hq[i];
    if (split) {
      float mm = -1e30f;
#pragma unroll
      for (int q = 0; q < 4; ++q) mm = fmaxf(mm, ml[q].x);
      float wq[4], ws_ = 0.f;
#pragma unroll
      for (int q = 0; q < 4; ++q) { wq[q] = ml[q].y * __builtin_amdgcn_exp2f(ml[q].x - mm); ws_ += wq[q]; }
      const float inv = 1.f / ws_;
      float o8[8];
#pragma unroll
      for (int e = 0; e < 8; ++e) o8[e] = 0.f;
#pragma unroll
      for (int q = 0; q < 4; ++q) {
        const float wv = wq[q] * inv;
#pragma unroll
        for (int e = 0; e < 4; ++e) { o8[2 * e] += bflo(pa[q][e]) * wv; o8[2 * e + 1] += bfhi(pa[q][e]) * wv; }
      }
      u32x4 o;
#pragma unroll
      for (int e = 0; e < 4; ++e) o[e] = pk2(o8[2 * e], o8[2 * e + 1]);
      *(u32x4*)(YA_DST(P, layer) + (size_t)R * 1024 + 768 + lane * 8) = o;
    }
  }
}

template <int MW, int NT>
__device__ __forceinline__ void merge_tile(const Params& P, int layer, int R0, int nt_, bf16_t* sm) {
  const int tid = otid(), lane = tid & 63, w = tid >> 6, r = lane & 31, h = lane >> 5;
  constexpr int NQ = NT / 2, LDW = 16 * NT + 8;
  const bf16_t* h1n = layer == 0 ? slot(P, 0) : slot(P, 3); bf16_t* merged = slot(P, 4);
  f32x16 mer[MW / 2][NQ]; zero_acc<MW, NT>(mer);
#pragma unroll 1
  for (int br = 0; br < 3; ++br) {
    f32x16 ga[MW / 2][NQ]; zero_acc<MW, NT>(ga);
    gemm_core<MW, NT>(h1n + (size_t)R0 * 1024, 1024, wbuf(P, W_IN) + (size_t)(7680 + 1024 * br + 16 * NT * nt_) * 1024, 1024, 1024, ga, sm);
    unsigned gp[MW / 2][NQ][8];
#pragma unroll
    for (int m = 0; m < MW / 2; ++m)
#pragma unroll
      for (int n = 0; n < NQ; ++n)
#pragma unroll
        for (int k = 0; k < 8; ++k) gp[m][n][k] = pk2(sigmoidf_(ga[m][n][2 * k]), sigmoidf_(ga[m][n][2 * k + 1]));
    f32x16 ya[MW / 2][NQ]; zero_acc<MW, NT>(ya);
    const bf16_t* yb = br == 1 ? YA_DST(P, layer) : slot(P, br == 0 ? 1 : 2);
    gemm_core<MW, NT>(yb + (size_t)R0 * 1024, 1024, wbuf(P, W_PM + (size_t)br * 2097152) + (size_t)(16 * NT * nt_) * 1024, 1024, 1024, ya, sm);
#pragma unroll
    for (int m = 0; m < MW / 2; ++m)
#pragma unroll
      for (int n = 0; n < NQ; ++n)
#pragma unroll
        for (int k = 0; k < 8; ++k) { mer[m][n][2 * k] += bflo(gp[m][n][k]) * ya[m][n][2 * k]; mer[m][n][2 * k + 1] += bfhi(gp[m][n][k]) * ya[m][n][2 * k + 1]; }
  }
  bf16_t* smw = sm + w * 32 * LDW;
#pragma unroll
  for (int m = 0; m < MW / 2; ++m) {
#pragma unroll
    for (int q = 0; q < 4; ++q)
#pragma unroll
      for (int i = 0; i < 4; ++i)
#pragma unroll
        for (int n = 0; n < NQ; ++n) smw[(8 * q + 4 * h + i) * LDW + 32 * n + r] = f2bf(mer[m][n][4 * q + i]);
    flush_pass<NT>(smw, merged + (size_t)(R0 + 16 * MW * w + 32 * m) * 1024 + 16 * NT * nt_, 1024, lane);
  }
}
__device__ void phase_merge(const Params& P, int layer, char* smc) {
  bf16_t* sm = (bf16_t*)smc;
  const int x = blockIdx.x & 7, loc = blockIdx.x >> 3, nloc = gridDim.x >> 3;
  for (int j = loc; j < 128; j += nloc) {
    const int jl = j & 63, mt = 16 * x + 8 * (j >> 6) + ((jl >> 1) & 7), nt = (jl & 1) | ((jl >> 4) << 1);
    merge_tile<2, 8>(P, layer, (mt >> 6) * PB + NCTX + (mt & 63) * 128, nt, sm);
  }
  if (layer == 0)
    for (int k = loc;; k += nloc) { const int sidx = x + 8 * k; if (sidx >= 64) break; merge_tile<2, 4>(P, layer, small_R0(sidx >> 4), sidx & 15, sm); }
}

template <int MW>
__device__ __forceinline__ void resid_tile(const Params& P, int layer, const bf16_t* A, int lda, int K, const bf16_t* Wt, int modchunk, bool srcInput, int R0, int nt_, bf16_t* sm, int kofs = 0, int klen = 0) {
  const int tid = otid(), lane = tid & 63, w = tid >> 6, r = lane & 31, h = lane >> 5;
  f32x16 acc[MW / 2][4]; zero_acc<MW, 8>(acc);
  gemm_core<MW, 8>(A + (size_t)R0 * lda + kofs, lda, Wt + (size_t)nt_ * 128 * K + kofs, K, klen ? klen : K, acc, sm);
  const float* gate = modrow(P, layer, R0) + modchunk * 1024 + nt_ * 128;
  float gv[4];
#pragma unroll
  for (int n = 0; n < 4; ++n) gv[n] = gate[32 * n + r];
  if (klen) {
#pragma unroll
    for (int m = 0; m < MW / 2; ++m)
#pragma unroll
      for (int q = 0; q < 4; ++q)
#pragma unroll
        for (int i = 0; i < 4; ++i) {
          float* xd = xdst_row(P, R0 + 16 * MW * w + 32 * m + 8 * q + 4 * h + i) + nt_ * 128;
#pragma unroll
          for (int n = 0; n < 4; ++n) atomicAdd(xd + 32 * n + r, gv[n] * acc[m][n][4 * q + i]);
        }
    return;
  }
  constexpr int NR = 8 * MW;
  float xin[2][4];
  {
    const float* xs = xsrc_row(P, srcInput, R0 + 16 * MW * w + 4 * h) + nt_ * 128;
#pragma unroll
    for (int n = 0; n < 4; ++n) xin[0][n] = xs[32 * n + r];
  }
#pragma unroll
  for (int j = 0; j < NR; ++j) {
    const int m = j >> 4, q = (j >> 2) & 3, i = j & 3;
    const int R = R0 + 16 * MW * w + 32 * m + 8 * q + 4 * h + i;
    if (j + 1 < NR) {
      const int jn = j + 1, Rn = R0 + 16 * MW * w + 32 * (jn >> 4) + 8 * ((jn >> 2) & 3) + 4 * h + (jn & 3);
      const float* xs = xsrc_row(P, srcInput, Rn) + nt_ * 128;
#pragma unroll
      for (int n = 0; n < 4; ++n) xin[(j + 1) & 1][n] = xs[32 * n + r];
    }
    float* xd = xdst_row(P, R) + nt_ * 128;
#pragma unroll
    for (int n = 0; n < 4; ++n) xd[32 * n + r] = xin[j & 1][n] + gv[n] * acc[m][n][4 * q + i];
  }
}
__device__ void phase_resid(const Params& P, int layer, const bf16_t* A, int lda, int K, const bf16_t* Wt, int modchunk, bool srcInput, char* smc) {
  bf16_t* sm = (bf16_t*)smc;
  const int x = blockIdx.x & 7, loc = blockIdx.x >> 3, nloc = gridDim.x >> 3, nks = K >> 7;
  for (int j = loc; j < 64; j += nloc) resid_tile<4>(P, layer, A, lda, K, Wt, modchunk, srcInput, big_R0(8 * x + ((j >> 1) & 7)), (j & 1) | ((j >> 4) << 1), sm);
  if (layer == 0)
    for (int q = blockIdx.x; q < 32 * nks; q += gridDim.x) { const int t = q / nks, ks = q - t * nks; resid_tile<2>(P, layer, A, lda, K, Wt, modchunk, false, small_R0(t >> 3), t & 7, sm, ks * 128, 128); }
}

template <int MW>
__device__ __forceinline__ void up_tile(const Params& P, int R0, int nt_, bf16_t* sm) {
  const int tid = otid(), lane = tid & 63, w = tid >> 6, r = lane & 31, h = lane >> 5;
  const bf16_t* h2 = slot(P, 0); bf16_t* U = slot(P, 3);
  f32x16 acc[MW / 2][4]; zero_acc<MW, 8>(acc);
  gemm_core<MW, 8>(h2 + (size_t)R0 * 1024, 1024, wbuf(P, W_UP) + (size_t)nt_ * 128 * 1024, 1024, 1024, acc, sm);
  bf16_t* smw = sm + w * 32 * 136;
#pragma unroll
  for (int m = 0; m < MW / 2; ++m) {
#pragma unroll
    for (int q = 0; q < 4; ++q)
#pragma unroll
      for (int i = 0; i < 4; ++i)
#pragma unroll
        for (int n = 0; n < 4; ++n) { const float v = fmaxf(acc[m][n][4 * q + i], 0.f); smw[(8 * q + 4 * h + i) * 136 + 32 * n + r] = f2bf(v * v); }
    flush_pass<8>(smw, U + (size_t)(R0 + 16 * MW * w + 32 * m) * 4096 + nt_ * 128, 4096, lane);
  }
}
__device__ void phase_up(const Params& P, int layer, char* smc) {
  bf16_t* sm = (bf16_t*)smc;
  for (int i = 0;; ++i) {
    bool big; int R0, nt;
    if (!gemm_unit(i, 32, layer == 0, big, R0, nt)) break;
    if (big) up_tile<4>(P, R0, nt, sm); else up_tile<2>(P, R0, nt, sm);
  }
}

__device__ void phase_fnorm(const Params& P) {
  const int tid = otid(), lane = tid & 63, w = tid >> 6;
  const int rstride = gridDim.x * 4;
  f32x4 xn[4], gfn[4];
#pragma unroll
  for (int i = 0; i < 4; ++i) gfn[i] = *(const f32x4*)(P.fnorm + 256 * i + lane * 4);
  int r = blockIdx.x * 4 + w;
  if (r < 2 * SEQ) {
#pragma unroll
    for (int i = 0; i < 4; ++i) xn[i] = *(const f32x4*)(P.out + (size_t)r * 1024 + 256 * i + lane * 4);
  }
  for (; r < 2 * SEQ; r += rstride) {
    float* xr = P.out + (size_t)r * 1024;
    f32x4 xv[4]; float ss = 0.f;
#pragma unroll
    for (int i = 0; i < 4; ++i) { xv[i] = xn[i]; ss += xv[i][0] * xv[i][0] + xv[i][1] * xv[i][1] + xv[i][2] * xv[i][2] + xv[i][3] * xv[i][3]; }
    if (r + rstride < 2 * SEQ) {
#pragma unroll
      for (int i = 0; i < 4; ++i) xn[i] = *(const f32x4*)(P.out + (size_t)(r + rstride) * 1024 + 256 * i + lane * 4);
    }
#pragma unroll
    for (int o = 32; o >= 1; o >>= 1) ss += shx(ss, o, lane);
    const float rstd = rsqrtf(ss * (1.f / 1024.f) + EPS);
#pragma unroll
    for (int i = 0; i < 4; ++i) { f32x4 o;
#pragma unroll
      for (int e = 0; e < 4; ++e) o[e] = xv[i][e] * rstd * gfn[i][e];
      *(f32x4*)(xr + 256 * i + lane * 4) = o; }
  }
}

constexpr int LDS_BYTES = 74752;
constexpr int NPHASE = 22;
__device__ void run_phase(const Params& P, int ph, char* sm) {
  if (ph == 0) { phase_prologue(P, sm); return; }
  if (ph == 21) { phase_fnorm(P); return; }
  const int layer = (ph - 1) / 10, k = (ph - 1) % 10;
  switch (k) {
    case 0: phase_norm(P, layer, 0, sm); break;
    case 1: phase_inproj(P, layer, sm); break;
    case 2: phase_conv(P, layer); break;
    case 3: phase_mix(P, layer, sm); break;
    case 4: phase_fin(P, layer); break;
    case 5: phase_merge(P, layer, sm); break;
    case 6: phase_resid(P, layer, slot(P, 4), 1024, 1024, wbuf(P, W_O), 2, layer == 0, sm); break;
    case 7: phase_norm(P, layer, 1, sm); break;
    case 8: phase_up(P, layer, sm); break;
    default: phase_resid(P, layer, slot(P, 3), 4096, 4096, wbuf(P, W_DN), 5, false, sm); break;
  }
}

__device__ __forceinline__ void grid_barrier(char* ws, unsigned gen) {
  asm volatile("s_waitcnt vmcnt(0)" ::: "memory");
  __syncthreads();
  unsigned* flags = (unsigned*)(ws + OFF_CNT + 1024); unsigned* rel = (unsigned*)(ws + OFF_CNT + 3584);
  const int tid = otid();
  if (tid < 64) {
    __builtin_amdgcn_fence(__ATOMIC_RELEASE, "agent");
    if (blockIdx.x == 0) {
      for (;;) {
        bool ok = true;
#pragma unroll
        for (int j = 0; j < 8; ++j) { const int idx = tid + 64 * j; if (idx != 0 && idx < (int)gridDim.x) { if (__hip_atomic_load(flags + idx, __ATOMIC_RELAXED, __HIP_MEMORY_SCOPE_AGENT) < gen) ok = false; } }
        if (__builtin_amdgcn_ballot_w64(!ok) == 0ull) break;
        __builtin_amdgcn_s_sleep(1);
      }
      if (tid == 0) __hip_atomic_store(rel, gen, __ATOMIC_RELAXED, __HIP_MEMORY_SCOPE_AGENT);
    } else if (tid == 0) {
      __hip_atomic_store(flags + blockIdx.x, gen, __ATOMIC_RELAXED, __HIP_MEMORY_SCOPE_AGENT);
      while (__hip_atomic_load(rel, __ATOMIC_RELAXED, __HIP_MEMORY_SCOPE_AGENT) < gen) __builtin_amdgcn_s_sleep(1);
    }
    __builtin_amdgcn_fence(__ATOMIC_ACQUIRE, "agent");
  }
  __syncthreads();
}

__global__ void __launch_bounds__(256, 2) mega(Params P, int ph0, int ph1, int coop) {
  extern __shared__ __attribute__((aligned(16))) char smem[];
  unsigned gen = 0;
  const int npre = 0;
  const int nit = npre + (ph1 - ph0);
  for (int it = 0; it < nit; ++it) {
    const int ph = it < npre ? it : ph0 + (it - npre);
    run_phase(P, ph, smem);
    if (coop && it + 1 < nit) {
      if (it == 0) cg::this_grid().sync();
      else grid_barrier(P.ws, ++gen);
    }
  }
}

extern "C" void kernel_launch(void* const* d_in, const int* in_sizes, int n_in, void* d_out, int out_size, void* d_ws, size_t ws_size, hipStream_t stream) {
  static int grid = 0;
  if (grid == 0) {
    if (n_in != 21 || ws_size < WS_NEED) { fprintf(stderr, "kernel_launch: need 21 inputs and %zu bytes of workspace; got %d, %zu\n", (size_t)WS_NEED, n_in, ws_size); grid = -1; return; }
    int dev = 0, cus = 0, per_cu = 0;
    hipGetDevice(&dev);
    hipDeviceGetAttribute(&cus, hipDeviceAttributeMultiprocessorCount, dev);
    if (hipFuncSetAttribute((const void*)mega, hipFuncAttributeMaxDynamicSharedMemorySize, LDS_BYTES) != hipSuccess) { fprintf(stderr, "kernel_launch: hipFuncSetAttribute failed\n"); grid = -1; return; }
    if (hipOccupancyMaxActiveBlocksPerMultiprocessor(&per_cu, (const void*)mega, 256, LDS_BYTES) != hipSuccess || per_cu < 1) { fprintf(stderr, "kernel_launch: occupancy query failed (%d)\n", per_cu); per_cu = 1; }
    if (per_cu > 2) per_cu = 2;
    grid = cus * per_cu;
    fprintf(stderr, "kernel_launch: grid %d (%d CUs x %d)\n", grid, cus, per_cu);
  }
  if (grid < 0) return;
  hipMemsetAsync((char*)d_ws + OFF_CNT, 0, 4096, stream);
  Params p{};
  const float** pp = (const float**)&p;
  for (int i = 0; i < 21; ++i) pp[i] = (const float*)d_in[i];
  p.out = (float*)d_out; p.ws = (char*)d_ws;
#if MULTI_LAUNCH
  for (int ph = 0; ph < NPHASE; ++ph) hipLaunchKernelGGL(mega, dim3(grid), dim3(256), LDS_BYTES, stream, p, ph, ph + 1, 0);
#else
  int ph0 = 0, ph1 = NPHASE, coop = 1;
  void* args[] = {&p, &ph0, &ph1, &coop};
  hipError_t e = hipLaunchCooperativeKernel((const void*)mega, dim3(grid), dim3(256), args, LDS_BYTES, stream);
  if (e != hipSuccess) fprintf(stderr, "cooperative launch failed: %s (grid %d)\n", hipGetErrorString(e), grid);
#endif
}
```
